# Optimizing an MI355X kernel written in HIP

```python
import math
import jax, jax.numpy as jnp
from jax import lax
import numpy as np

D_MODEL = 2048
BATCH = 4
SEQ = 4096
DEPTH = 2

N_MIXERS = 2
N_RWKV_LAYERS = (DEPTH + 1) // 2
N_ATTN_LAYERS = DEPTH // 2

RWKV_HEAD_SIZE = 64
RWKV_HEADS = D_MODEL // RWKV_HEAD_SIZE
DECAY_LORA = 96
AAA_LORA = 96
GATE_LORA = 256
N_SHIFT_MIX = 6
GN_EPS = 64e-5

ATTN_HEAD_DIM = 128
ATTN_HEADS_PER_GROUP = D_MODEL // ATTN_HEAD_DIM
ATTN_GROUP_WIDTH = ATTN_HEADS_PER_GROUP * ATTN_HEAD_DIM
DILATED_GROUPS = ((128, 1), (512, 4), (2048, 16))
N_GROUPS = len(DILATED_GROUPS)
MASK_VALUE = -1e30

D_FF = 5632
CONV_WIDTH = 3

LN_EPS = 1e-5
DEEPNORM_ALPHA = (2.0 * DEPTH) ** 0.25
DEEPNORM_BETA = (8.0 * DEPTH) ** -0.25

kernel_name = "rwkv7_dilated_attn_convglu_deepnorm_hybrid"


def layer_norm(x, g, b):
    xf = x.astype(jnp.float32)
    mu = jnp.mean(xf, axis=-1, keepdims=True)
    var = jnp.mean(jnp.square(xf - mu), axis=-1, keepdims=True)
    return ((xf - mu) * lax.rsqrt(var + LN_EPS) * g + b).astype(x.dtype)


def token_shift(x):
    return jnp.pad(x, ((0, 0), (1, 0), (0, 0)))[:, :-1]


def rwkv7_time_mix(x, mu, w_rkv, w0, w1, w2, a0, a1, a2, g1, g2, k_k, k_a, r_k, gn_g, gn_b, w_out):
    bsz, seq, dm = x.shape
    H, N = RWKV_HEADS, RWKV_HEAD_SIZE
    xx = token_shift(x) - x
    xr, xw, xk, xv, xa, xg = [x + xx * mu[i] for i in range(N_SHIFT_MIX)]
    rkv = jnp.einsum('cbsd,cde->cbse', jnp.stack([xr, xk, xv]), w_rkv)
    r, k, v = rkv[0], rkv[1], rkv[2]
    w = -jax.nn.softplus(-(w0 + jnp.tanh(xw @ w1) @ w2)) - 0.5
    decay = jnp.exp(-jnp.exp(w.astype(jnp.float32)))
    a = jax.nn.sigmoid(a0 + (xa @ a1) @ a2)
    g = jax.nn.sigmoid(xg @ g1) @ g2
    kk = (k * k_k).reshape(bsz, seq, H, N).astype(jnp.float32)
    kk = kk * lax.rsqrt(jnp.maximum(jnp.sum(kk * kk, axis=-1, keepdims=True), 1e-24))
    k = k * (1.0 + (a - 1.0) * k_a)

    def heads(t):
        return t.reshape(bsz, seq, H, N).astype(jnp.float32)

    r_h, k_h, v_h, a_h, w_h = heads(r), heads(k), heads(v), heads(a), heads(decay)

    def time_major(t):
        return jnp.swapaxes(t, 0, 1)

    def step(state, inp):
        r_t, w_t, k_t, v_t, kk_t, b_t = inp
        sa = jnp.einsum('bhvk,bhk->bhv', state, -kk_t)
        state = (state * w_t[:, :, None, :]
                 + sa[..., None] * b_t[:, :, None, :]
                 + v_t[..., None] * k_t[:, :, None, :])
        return state, jnp.einsum('bhvk,bhk->bhv', state, r_t)

    state0 = jnp.zeros((bsz, H, N, N), jnp.float32)
    _, y = lax.scan(step, state0, (time_major(r_h), time_major(w_h), time_major(k_h),
                                   time_major(v_h), time_major(kk), time_major(kk * a_h)))
    y = time_major(y)
    mean = jnp.mean(y, axis=-1, keepdims=True)
    var = jnp.mean(jnp.square(y - mean), axis=-1, keepdims=True)
    y = ((y - mean) * lax.rsqrt(var + GN_EPS)).reshape(bsz, seq, dm) * gn_g + gn_b
    bonus = jnp.sum(r_h * k_h * r_k, axis=-1, keepdims=True) * v_h
    y = y + bonus.reshape(bsz, seq, dm)
    return (y * g).astype(x.dtype) @ w_out


def dilated_group_attention(q, k, v, dilation, span):
    bsz, seq, H, hd = q.shape
    seg = dilation * span
    s_pad = -(-seq // seg) * seg
    nb = s_pad // seg
    pad = ((0, 0), (0, s_pad - seq), (0, 0), (0, 0))

    def to_blocks(t):
        t = jnp.pad(t, pad).reshape(bsz, nb, span, dilation, H, hd)
        return t.transpose(0, 4, 3, 1, 2, 5)

    qb, kb, vb = to_blocks(q), to_blocks(k), to_blocks(v)

    def with_prev(t):
        prev = jnp.pad(t, ((0, 0), (0, 0), (0, 0), (1, 0), (0, 0), (0, 0)))[:, :, :, :-1]
        return jnp.concatenate([prev, t], axis=4)

    kc, vc = with_prev(kb), with_prev(vb)
    scores = jnp.einsum('bhrnqd,bhrnkd->bhrnqk', qb, kc).astype(jnp.float32) * (hd ** -0.5)
    n_idx = jnp.arange(nb)[:, None, None]
    qi = jnp.arange(span)[None, :, None]
    kj = jnp.arange(2 * span)[None, None, :]
    dist = qi + span - kj
    valid = (dist >= 0) & (dist <= span) & ((n_idx > 0) | (kj >= span))
    scores = jnp.where(valid, scores, MASK_VALUE)
    lse = jax.nn.logsumexp(scores, axis=-1)
    p = jnp.exp(scores - lse[..., None]).astype(v.dtype)
    o = jnp.einsum('bhrnqk,bhrnkd->bhrnqd', p, vc)
    o = o.transpose(0, 3, 4, 2, 1, 5).reshape(bsz, s_pad, H, hd)[:, :seq]
    lse = lse.transpose(0, 3, 4, 2, 1).reshape(bsz, s_pad, H)[:, :seq]
    return o, lse


def dilated_attention_mixer(x, w_in, w_out):
    bsz, seq, _ = x.shape
    H, hd = ATTN_HEADS_PER_GROUP, ATTN_HEAD_DIM
    qkv = (x @ w_in).reshape(bsz, seq, N_GROUPS, 3, H, hd)
    outs, lses = [], []
    for gi, (window, dilation) in enumerate(DILATED_GROUPS):
        o, lse = dilated_group_attention(qkv[:, :, gi, 0], qkv[:, :, gi, 1], qkv[:, :, gi, 2],
                                         dilation, window // dilation)
        outs.append(o)
        lses.append(lse)
    weights = jax.nn.softmax(jnp.stack(lses), axis=0).astype(x.dtype)
    o = jnp.einsum('gbsh,gbshd->bshd', weights, jnp.stack(outs))
    return o.reshape(bsz, seq, H * hd) @ w_out


def conv_glu_ffn(x, w_up, conv_w, conv_b, w_down):
    seq = x.shape[1]
    h = x @ w_up
    gate, up = h[..., :D_FF], h[..., D_FF:]
    gp = jnp.pad(gate, ((0, 0), (CONV_WIDTH - 1, 0), (0, 0)))
    acc = conv_b
    for j in range(CONV_WIDTH):
        acc = acc + gp[:, j:j + seq] * conv_w[j]
    return (jax.nn.silu(acc) * up) @ w_down


def setup_inputs(seed: int = 0) -> dict:
    key = jax.random.key(seed)
    ks = jax.random.split(key, 32)
    D, H, N = D_MODEL, RWKV_HEADS, RWKV_HEAD_SIZE
    nr, na = N_RWKV_LAYERS, N_ATTN_LAYERS
    f32 = jnp.float32

    def nrm(k, shape, scale):
        return jax.random.normal(k, shape, f32) * scale

    return {
        'x': nrm(ks[0], (BATCH, SEQ, D), 1.0),
        'rwkv_mu': jax.random.uniform(ks[1], (nr, N_SHIFT_MIX, D), f32),
        'rwkv_w_rkv': nrm(ks[2], (nr, 3, D, D), D ** -0.5),
        'rwkv_w0': jax.random.uniform(ks[3], (nr, D), f32, minval=-6.0, maxval=1.0),
        'rwkv_w1': nrm(ks[4], (nr, D, DECAY_LORA), D ** -0.5),
        'rwkv_w2': nrm(ks[5], (nr, DECAY_LORA, D), 0.5 * DECAY_LORA ** -0.5),
        'rwkv_a0': nrm(ks[6], (nr, D), 0.5),
        'rwkv_a1': nrm(ks[7], (nr, D, AAA_LORA), D ** -0.5),
        'rwkv_a2': nrm(ks[8], (nr, AAA_LORA, D), 0.5 * AAA_LORA ** -0.5),
        'rwkv_g1': nrm(ks[9], (nr, D, GATE_LORA), D ** -0.5),
        'rwkv_g2': nrm(ks[10], (nr, GATE_LORA, D), GATE_LORA ** -0.5),
        'rwkv_k_k': 0.85 + nrm(ks[11], (nr, D), 0.05),
        'rwkv_k_a': 1.0 + nrm(ks[12], (nr, D), 0.05),
        'rwkv_r_k': nrm(ks[13], (nr, H, N), 0.1),
        'rwkv_gn_g': 1.0 + nrm(ks[14], (nr, D), 0.05),
        'rwkv_gn_b': nrm(ks[15], (nr, D), 0.01),
        'rwkv_w_out': nrm(ks[16], (nr, D, D), DEEPNORM_BETA * D ** -0.5),
        'attn_w_in': nrm(ks[17], (na, D, N_GROUPS * 3 * ATTN_GROUP_WIDTH), D ** -0.5),
        'attn_w_out': nrm(ks[18], (na, ATTN_GROUP_WIDTH, D), DEEPNORM_BETA * ATTN_GROUP_WIDTH ** -0.5),
        'ffn_w_up': nrm(ks[19], (DEPTH, D, 2 * D_FF), D ** -0.5),
        'ffn_conv_w': nrm(ks[20], (DEPTH, CONV_WIDTH, D_FF), CONV_WIDTH ** -0.5),
        'ffn_conv_b': nrm(ks[21], (DEPTH, D_FF), 0.01),
        'ffn_w_down': nrm(ks[22], (DEPTH, D_FF, D), DEEPNORM_BETA * D_FF ** -0.5),
        'ln_mix_g': 1.0 + nrm(ks[23], (DEPTH, D), 0.05),
        'ln_mix_b': nrm(ks[24], (DEPTH, D), 0.01),
        'ln_ffn_g': 1.0 + nrm(ks[25], (DEPTH, D), 0.05),
        'ln_ffn_b': nrm(ks[26], (DEPTH, D), 0.01),
    }


def reference(x, rwkv_mu, rwkv_w_rkv, rwkv_w0, rwkv_w1, rwkv_w2, rwkv_a0, rwkv_a1, rwkv_a2,
              rwkv_g1, rwkv_g2, rwkv_k_k, rwkv_k_a, rwkv_r_k, rwkv_gn_g, rwkv_gn_b, rwkv_w_out,
              attn_w_in, attn_w_out, ffn_w_up, ffn_conv_w, ffn_conv_b, ffn_w_down,
              ln_mix_g, ln_mix_b, ln_ffn_g, ln_ffn_b):
    for i in range(DEPTH):
        j = i // N_MIXERS
        if i % N_MIXERS == 0:
            m = rwkv7_time_mix(x, rwkv_mu[j], rwkv_w_rkv[j], rwkv_w0[j], rwkv_w1[j], rwkv_w2[j],
                               rwkv_a0[j], rwkv_a1[j], rwkv_a2[j], rwkv_g1[j], rwkv_g2[j],
                               rwkv_k_k[j], rwkv_k_a[j], rwkv_r_k[j], rwkv_gn_g[j], rwkv_gn_b[j],
                               rwkv_w_out[j])
        else:
            m = dilated_attention_mixer(x, attn_w_in[j], attn_w_out[j])
        x = layer_norm(DEEPNORM_ALPHA * x + m, ln_mix_g[i], ln_mix_b[i])
        f = conv_glu_ffn(x, ffn_w_up[i], ffn_conv_w[i], ffn_conv_b[i], ffn_w_down[i])
        x = layer_norm(DEEPNORM_ALPHA * x + f, ln_ffn_g[i], ln_ffn_b[i])
    return x
```

```cpp
#include <hip/hip_runtime.h>
#include <hip/hip_cooperative_groups.h>
#include <cstdio>
#include <cstdint>
namespace cg = cooperative_groups;

#define LAS __attribute__((address_space(3)))
typedef unsigned short bf16_t;
typedef short bf16x8 __attribute__((ext_vector_type(8)));
typedef float f32x4 __attribute__((ext_vector_type(4)));
typedef float f32x2 __attribute__((ext_vector_type(2)));
typedef unsigned u32x4 __attribute__((ext_vector_type(4)));
typedef unsigned u32x2 __attribute__((ext_vector_type(2)));

constexpr int D = 2048, SEQ = 4096, NB = 4, M = NB * SEQ;
constexpr int FF = 5632, FF2 = 2 * FF;
constexpr int NQKV = 6144;
constexpr float LN_EPS = 1e-5f, GN_EPS = 64e-5f;
constexpr float ALPHA = 1.41421356237309515f;

constexpr size_t MiB = 1u << 20;
constexpr size_t O_BT1 = 1 * MiB, O_BT2 = 28 * MiB, O_WOR = 31 * MiB, O_WUP0 = 39 * MiB, O_WDN0 = 83 * MiB, O_H = 105 * MiB;
constexpr size_t O_XM = 129 * MiB, O_DEC = 129 * MiB, O_AA = 257 * MiB, O_RKV = 321 * MiB, O_G = 513 * MiB, O_BONUS = 577 * MiB, O_YG = 579 * MiB;
constexpr size_t O_RES = 513 * MiB;
constexpr size_t O_PRE = 129 * MiB, O_X1B = 129 * MiB, O_HF0 = 193 * MiB, O_PRE2 = 129 * MiB, O_X2B = 1 * MiB, O_WIN = 321 * MiB, O_WOA = 687 * MiB;
constexpr size_t O_QKV = 129 * MiB, O_OG = 401 * MiB, O_LSE = 593 * MiB, O_OM = 1 * MiB, O_PRE3 = 65 * MiB, O_X3B = 1 * MiB, O_WUP1 = 643 * MiB, O_WDN1 = 105 * MiB;
constexpr size_t O_HF1 = 259 * MiB, O_PRE4 = 65 * MiB;
constexpr size_t WS_NEED = 696 * MiB;
constexpr int LDS_BYTES = 147456;

typedef __bf16 bf16x2_t __attribute__((ext_vector_type(2)));
__device__ __forceinline__ unsigned cvt_pk_bf16(float lo, float hi) { const f32x2 v = {lo, hi}; return __builtin_bit_cast(unsigned, __builtin_convertvector(v, bf16x2_t)); }
__device__ __forceinline__ float bflo(unsigned w) { return __builtin_bit_cast(float, w << 16); }
__device__ __forceinline__ float bfhi(unsigned w) { return __builtin_bit_cast(float, w & 0xffff0000u); }
template <int CTRL> __device__ __forceinline__ float dppf(float v) { return __builtin_bit_cast(float, __builtin_amdgcn_update_dpp(0, __builtin_bit_cast(int, v), CTRL, 0xf, 0xf, false)); }
__device__ __forceinline__ float red16(float v) { v += dppf<0xB1>(v); v += dppf<0x4E>(v); v += dppf<0x141>(v); v += dppf<0x128>(v); return v; }
__device__ __forceinline__ float red8(float v) { v += dppf<0xB1>(v); v += dppf<0x4E>(v); v += dppf<0x141>(v); return v; }
__device__ __forceinline__ float wave_sum(float v) {
    v += dppf<0xB1>(v); v += dppf<0x4E>(v); v += dppf<0x141>(v); v += dppf<0x128>(v);
    v += __shfl_xor(v, 16); v += __shfl_xor(v, 32);
    return v;
}
__device__ __forceinline__ float sigmoidf_(float x) { return __builtin_amdgcn_rcpf(1.0f + __expf(-x)); }
__device__ __forceinline__ float tanh_fast(float x) { return 1.0f - 2.0f * __builtin_amdgcn_rcpf(1.0f + __expf(2.0f * x)); }

namespace pg8 {
constexpr int BM = 256, BK = 64, HALF = 128, HTB = HALF * BK * 2, STAGE_BYTES = 8 * HTB, NXCD = 8, WGM = 8;
__host__ __device__ __forceinline__ int lds_byte(int r, int c) { const int st = (r >> 4) * 2 + (c >> 5), rr = r & 15, cc = c & 31, ob = rr * 64 + cc * 2; return st * 1024 + (ob ^ (((ob >> 9) & 1) << 5)); }
__host__ __device__ __forceinline__ void stage_rc(int b, int& R, int& C) { const int st = b / 1024, sb = b % 1024, swz = sb ^ (((sb >> 9) & 1) << 5); R = (st >> 1) * 16 + swz / 64; C = (st & 1) * 32 + (swz % 64) / 2; }
__host__ __device__ __forceinline__ int perm32(int rho) { const int n = rho >> 4, i = rho & 15; return 8 * (i >> 2) + 4 * n + (i & 3); }

struct Unit { int pm, pn; };
struct Gemm { const bf16_t* A; const bf16_t* Bt; int K, lda, ldb; };

struct Order {
    int nM, nN, per, nsub, aoff, G, c;
    __device__ void init(int nM_, int nN_, int nsub_, int aoff_, int G_, int c_) { nM = nM_; nN = nN_; per = nM_ * nN_; nsub = nsub_; aoff = aoff_; G = G_; c = c_; }
    __device__ bool next(int i, Unit& u) const {
        const long L = (long)i * G + c; if (L >= (long)per * nsub) return false;
        const int sub = (int)(L / per); int wgid = (int)(L % per);
        { const int q = per / NXCD, r = per % NXCD, xcd = wgid % NXCD, off = wgid / NXCD; wgid = (xcd < r ? xcd * (q + 1) : r * (q + 1) + (xcd - r) * q) + off; }
        const int nig = WGM * nN, gid = wgid / nig, fm = gid * WGM, gsz = (nM - fm) < WGM ? (nM - fm) : WGM;
        u.pm = sub * aoff + fm + ((wgid % nig) % gsz); u.pn = sub * nN + (wgid % nig) / gsz; return true;
    }
};

template <class Epi>
__device__ __forceinline__ void gemm_phase(LAS unsigned char* lds, const Gemm g, const Order& S, const Epi& E) {
    int tid_ = threadIdx.x; asm volatile("" : "+v"(tid_));
    const int tid = tid_, wid = __builtin_amdgcn_readfirstlane(tid >> 6), lane = tid & 63, wr = wid >> 2, wc = wid & 3, fr = lane & 15, fq = lane >> 4;
    const int K = g.K, nt = K / BK;
    unsigned voffA[2], voffB[2];
#pragma unroll
    for (int i = 0; i < 2; ++i) { int R, C; stage_rc(tid * 16 + i * 8192, R, C); const int Rb = (R & ~31) + perm32(R & 31);
        voffA[i] = (unsigned)(R * g.lda + C) * 2u; voffB[i] = (unsigned)(Rb * g.ldb + C) * 2u; }
    const size_t kstep = (size_t)(BK * 2);
    const size_t hA = (size_t)HALF * g.lda * 2, hB = (size_t)HALF * g.ldb * 2;
    const size_t tA = 2 * hA, tB = 2 * hB;
    const unsigned ldsw = (unsigned)wid * 1024u;
    const int aoff = lds_byte(wr * 64 + fr, fq * 8), boff = lds_byte(wc * 32 + fr, fq * 8);
#define PG8_SA(b, h) (((b) * 2 + (h)) * HTB)
#define PG8_SB(b, h) ((4 + (b) * 2 + (h)) * HTB)
#define PG8_STAGE(bufoff, gbase, voff) do { _Pragma("unroll") for (int _i = 0; _i < 2; ++_i) \
        __builtin_amdgcn_global_load_lds((const unsigned*)((const char*)(gbase) + (voff)[_i]), (LAS unsigned*)(lds + (bufoff) + ldsw + _i * 8192), 16, 0, 0); } while (0)
#define PG8_LDA(dst, b, h) do { _Pragma("unroll") for (int m = 0; m < 4; ++m) _Pragma("unroll") for (int k = 0; k < 2; ++k) dst[m][k] = *(const LAS bf16x8*)(lds + PG8_SA(b, h) + aoff + m * 2048 + k * 1024); } while (0)
#define PG8_LDB(dst, b, h) do { _Pragma("unroll") for (int n = 0; n < 2; ++n) _Pragma("unroll") for (int k = 0; k < 2; ++k) dst[n][k] = *(const LAS bf16x8*)(lds + PG8_SB(b, h) + boff + n * 2048 + k * 1024); } while (0)
#define PG8_MMA(ai, bj, At, Bt) do { __builtin_amdgcn_s_setprio(1); _Pragma("unroll") for (int m = 0; m < 4; ++m) _Pragma("unroll") for (int n = 0; n < 2; ++n) _Pragma("unroll") for (int k = 0; k < 2; ++k) \
        acc[ai][bj][m][n] = __builtin_amdgcn_mfma_f32_16x16x32_bf16(Bt[n][k], At[m][k], acc[ai][bj][m][n], 0, 0, 0); __builtin_amdgcn_s_setprio(0); } while (0)
#define PG8_WAIT_V(n) asm volatile("s_waitcnt vmcnt(" #n ")" ::: "memory")
#define PG8_WAIT_L(n) asm volatile("s_waitcnt lgkmcnt(" #n ")" ::: "memory")
#define PG8_BAR __builtin_amdgcn_s_barrier()
#define PG8_SCHED __builtin_amdgcn_sched_barrier(0)
    Unit cur, nxt; int ui = 0;
    if (!S.next(0, cur)) return;
    f32x4 acc[2][2][4][2];
#pragma unroll
    for (int a = 0; a < 2; ++a)
#pragma unroll
        for (int b = 0; b < 2; ++b)
#pragma unroll
            for (int m = 0; m < 4; ++m)
#pragma unroll
                for (int n = 0; n < 2; ++n) acc[a][b][m][n] = (f32x4){0.f, 0.f, 0.f, 0.f};
    bf16x8 At[4][2], B0[2][2], B1[2][2];
    const char* cA = (const char*)g.A + (size_t)cur.pm * tA; const char* cB = (const char*)g.Bt + (size_t)cur.pn * tB;
    PG8_STAGE(PG8_SB(0, 0), cB, voffB); PG8_STAGE(PG8_SA(0, 0), cA, voffA); PG8_STAGE(PG8_SB(0, 1), cB + hB, voffB); PG8_STAGE(PG8_SA(0, 1), cA + hA, voffA);
    if (wr == 1) PG8_BAR;
    PG8_WAIT_V(4); PG8_BAR;
    PG8_STAGE(PG8_SB(1, 0), cB + kstep, voffB); PG8_STAGE(PG8_SA(1, 0), cA + kstep, voffA); PG8_STAGE(PG8_SB(1, 1), cB + hB + kstep, voffB);
    PG8_WAIT_V(6); PG8_BAR;
    for (;;) {
        const bool has_next = S.next(ui + 1, nxt);
        const char* nA = has_next ? (const char*)g.A + (size_t)nxt.pm * tA : cA; const char* nB = has_next ? (const char*)g.Bt + (size_t)nxt.pn * tB : cB;
        for (int t = 0; t < nt; t += 2) {
            const bool last = (t == nt - 2);
            const char* a1 = cA + (size_t)(t + 1) * kstep;
            const char* a2 = last ? nA : cA + (size_t)(t + 2) * kstep; const char* b2 = last ? nB : cB + (size_t)(t + 2) * kstep;
            const char* a3 = a2 + kstep; const char* b3 = b2 + kstep;
            PG8_LDB(B0, 0, 0); PG8_SCHED; PG8_LDA(At, 0, 0); PG8_STAGE(PG8_SA(1, 1), a1 + hA, voffA);
            PG8_WAIT_L(8); PG8_BAR; PG8_WAIT_L(0); PG8_MMA(0, 0, At, B0); PG8_BAR; PG8_SCHED;
            PG8_LDB(B1, 0, 1); PG8_STAGE(PG8_SB(0, 0), b2, voffB);
            PG8_BAR; PG8_WAIT_L(0); PG8_MMA(0, 1, At, B1); PG8_BAR;
            PG8_LDA(At, 0, 1); PG8_STAGE(PG8_SA(0, 0), a2, voffA);
            PG8_BAR; PG8_WAIT_L(0); PG8_MMA(1, 0, At, B0); PG8_BAR; PG8_SCHED;
            PG8_STAGE(PG8_SB(0, 1), b2 + hB, voffB);
            PG8_WAIT_V(6); PG8_BAR; PG8_MMA(1, 1, At, B1); PG8_BAR;
            PG8_LDB(B0, 1, 0); PG8_SCHED; PG8_LDA(At, 1, 0); PG8_STAGE(PG8_SA(0, 1), a2 + hA, voffA);
            PG8_WAIT_L(8); PG8_BAR; PG8_WAIT_L(0); PG8_MMA(0, 0, At, B0); PG8_BAR; PG8_SCHED;
            PG8_LDB(B1, 1, 1); PG8_STAGE(PG8_SB(1, 0), b3, voffB);
            PG8_BAR; PG8_WAIT_L(0); PG8_MMA(0, 1, At, B1); PG8_BAR;
            PG8_LDA(At, 1, 1); PG8_STAGE(PG8_SA(1, 0), a3, voffA);
            PG8_BAR; PG8_WAIT_L(0); PG8_MMA(1, 0, At, B0); PG8_BAR; PG8_SCHED;
            PG8_STAGE(PG8_SB(1, 1), b3 + hB, voffB);
            PG8_WAIT_V(6); PG8_BAR; PG8_MMA(1, 1, At, B1); PG8_BAR;
        }
        E(acc, cur, wr, wc, fr, fq);
        if (!has_next) break;
#pragma unroll
        for (int a = 0; a < 2; ++a)
#pragma unroll
            for (int b = 0; b < 2; ++b)
#pragma unroll
                for (int m = 0; m < 4; ++m)
#pragma unroll
                    for (int n = 0; n < 2; ++n) acc[a][b][m][n] = (f32x4){0.f, 0.f, 0.f, 0.f};
        cur = nxt; cA = nA; cB = nB; ++ui;
    }
    PG8_WAIT_V(0);
    if (wr == 0) PG8_BAR;
    PG8_BAR;
#undef PG8_SA
#undef PG8_SB
#undef PG8_STAGE
#undef PG8_LDA
#undef PG8_LDB
#undef PG8_MMA
#undef PG8_WAIT_V
#undef PG8_WAIT_L
#undef PG8_BAR
#undef PG8_SCHED
}

struct EpiArgs { void* o0; void* o1; void* o2; const float* p0; const float* p1; size_t sstride; int ldc; int nN; };
template <int MODE> struct Epi {
    EpiArgs a;
    __device__ __forceinline__ void operator()(const f32x4 (&acc)[2][2][4][2], const Unit& u, int wr, int wc, int fr, int fq) const {
        const int sub = u.pn / a.nN;
        const int row0 = (u.pm & 63) * BM + wr * 64 + fr, col0 = (u.pn - sub * a.nN) * BM + wc * 32 + 8 * fq;
        if constexpr (MODE == 0 || MODE == 1) {
            bf16_t* base = (bf16_t*)a.o0 + (size_t)sub * a.sstride;
#pragma unroll
            for (int ai = 0; ai < 2; ++ai)
#pragma unroll
                for (int m = 0; m < 4; ++m) { bf16_t* rowp = base + (size_t)(row0 + ai * HALF + m * 16) * a.ldc + col0;
#pragma unroll
                    for (int bj = 0; bj < 2; ++bj) { f32x4 v0 = acc[ai][bj][m][0], v1 = acc[ai][bj][m][1];
                        if constexpr (MODE == 1) {
                            if (sub == 0) {
#pragma unroll
                                for (int j = 0; j < 4; ++j) { v0[j] = tanh_fast(v0[j]); v1[j] = tanh_fast(v1[j]); } }
                            else if (sub == 2) {
#pragma unroll
                                for (int j = 0; j < 4; ++j) { v0[j] = sigmoidf_(v0[j]); v1[j] = sigmoidf_(v1[j]); } }
                        }
                        u32x4 w; w.x = cvt_pk_bf16(v0[0], v0[1]); w.y = cvt_pk_bf16(v0[2], v0[3]); w.z = cvt_pk_bf16(v1[0], v1[1]); w.w = cvt_pk_bf16(v1[2], v1[3]);
                        *(u32x4*)(rowp + bj * HALF) = w; } }
        } else if constexpr (MODE == 2) {
            if (sub == 0) {
#pragma unroll
                for (int bj = 0; bj < 2; ++bj) {
                    const int c = col0 + bj * HALF;
                    const f32x4 p0v = *(const f32x4*)(a.p0 + c), p1v = *(const f32x4*)(a.p0 + c + 4);
#pragma unroll
                    for (int ai = 0; ai < 2; ++ai)
#pragma unroll
                        for (int m = 0; m < 4; ++m) { bf16_t* dst = (bf16_t*)a.o0 + (size_t)(row0 + ai * HALF + m * 16) * D + c;
                            f32x4 v0 = acc[ai][bj][m][0] + p0v, v1 = acc[ai][bj][m][1] + p1v;
#pragma unroll
                            for (int j = 0; j < 4; ++j) {
                                v0[j] = -0.6065306597126334f * __builtin_amdgcn_rcpf(1.0f + __expf(-v0[j]));
                                v1[j] = -0.6065306597126334f * __builtin_amdgcn_rcpf(1.0f + __expf(-v1[j])); }
                            u32x4 w8; w8.x = cvt_pk_bf16(v0[0], v0[1]); w8.y = cvt_pk_bf16(v0[2], v0[3]); w8.z = cvt_pk_bf16(v1[0], v1[1]); w8.w = cvt_pk_bf16(v1[2], v1[3]);
                            *(u32x4*)dst = w8; asm volatile("" ::: "memory"); }
                }
            } else if (sub == 1) {
#pragma unroll
                for (int bj = 0; bj < 2; ++bj) {
                    const int c = col0 + bj * HALF;
                    const f32x4 p0v = *(const f32x4*)(a.p1 + c), p1v = *(const f32x4*)(a.p1 + c + 4);
#pragma unroll
                    for (int ai = 0; ai < 2; ++ai)
#pragma unroll
                        for (int m = 0; m < 4; ++m) { bf16_t* dst = (bf16_t*)a.o1 + (size_t)(row0 + ai * HALF + m * 16) * D + c;
                            f32x4 v0 = acc[ai][bj][m][0] + p0v, v1 = acc[ai][bj][m][1] + p1v;
#pragma unroll
                            for (int j = 0; j < 4; ++j) { v0[j] = sigmoidf_(v0[j]); v1[j] = sigmoidf_(v1[j]); }
                            u32x4 w; w.x = cvt_pk_bf16(v0[0], v0[1]); w.y = cvt_pk_bf16(v0[2], v0[3]); w.z = cvt_pk_bf16(v1[0], v1[1]); w.w = cvt_pk_bf16(v1[2], v1[3]);
                            *(u32x4*)dst = w; asm volatile("" ::: "memory"); }
                }
            } else {
#pragma unroll
                for (int ai = 0; ai < 2; ++ai)
#pragma unroll
                    for (int m = 0; m < 4; ++m) { bf16_t* rowp = (bf16_t*)a.o2 + (size_t)(row0 + ai * HALF + m * 16) * D + col0;
#pragma unroll
                        for (int bj = 0; bj < 2; ++bj) { const f32x4 v0 = acc[ai][bj][m][0], v1 = acc[ai][bj][m][1];
                            u32x4 w; w.x = cvt_pk_bf16(v0[0], v0[1]); w.y = cvt_pk_bf16(v0[2], v0[3]); w.z = cvt_pk_bf16(v1[0], v1[1]); w.w = cvt_pk_bf16(v1[2], v1[3]);
                            *(u32x4*)(rowp + bj * HALF) = w; } }
            }
        } else if constexpr (MODE == 5) {
            bf16_t* ACT = (bf16_t*)a.o0; float* GS = (float*)a.o1; float* US = (float*)a.o2;
            const int chan0 = u.pn * HALF + wc * 32 + 8 * fq;
#pragma unroll
            for (int n = 0; n < 2; ++n) {
                const int c = chan0 + 4 * n;
                const f32x4 w0 = *(const f32x4*)(a.p0 + c), w1 = *(const f32x4*)(a.p0 + FF + c), w2 = *(const f32x4*)(a.p0 + 2 * FF + c), cb = *(const f32x4*)(a.p1 + c);
#pragma unroll
                for (int ai = 0; ai < 2; ++ai)
#pragma unroll
                    for (int m = 0; m < 4; ++m) {
                        const f32x4 g0 = acc[ai][0][m][n], up = acc[ai][1][m][n];
                        f32x4 g1, g2;
#pragma unroll
                        for (int j = 0; j < 4; ++j) {
                            const int ln = (int)(threadIdx.x & 63);
                            const float cur = g0[j];
                            const float prev = (m > 0) ? acc[ai][0][m > 0 ? m - 1 : 0][n][j] : 0.f;
                            const float t1c = __builtin_bit_cast(float, __builtin_amdgcn_update_dpp(0, __builtin_bit_cast(int, cur), 0x111, 0xf, 0xf, true)), t1p = __shfl(prev, (ln + 15) & 63);
                            const float t2c = __builtin_bit_cast(float, __builtin_amdgcn_update_dpp(0, __builtin_bit_cast(int, cur), 0x112, 0xf, 0xf, true)), t2p = __shfl(prev, (ln + 14) & 63);
                            g1[j] = (fr >= 1) ? t1c : t1p;
                            g2[j] = (fr >= 2) ? t2c : t2p;
                        }
                        const f32x4 av = cb + w0 * g2 + w1 * g1 + w2 * g0;
                        f32x4 o;
#pragma unroll
                        for (int j = 0; j < 4; ++j) o[j] = av[j] * __builtin_amdgcn_rcpf(1.0f + __expf(-av[j])) * up[j];
                        const int row = row0 + ai * HALF + m * 16;
                        if (!(m == 0 && fr < 2)) { u32x2 w; w.x = cvt_pk_bf16(o[0], o[1]); w.y = cvt_pk_bf16(o[2], o[3]); *(u32x2*)(ACT + (size_t)row * FF + c) = w; }
                        if (m == 0 && fr < 2) { const int grp = row >> 6; *(f32x4*)(GS + ((size_t)grp * 4 + fr) * FF + c) = g0; *(f32x4*)(US + ((size_t)grp * 2 + fr) * FF + c) = up; }
                        if (m == 3 && fr >= 14) { const int grp = row >> 6; *(f32x4*)(GS + ((size_t)grp * 4 + 2 + (fr - 14)) * FF + c) = g0; }
                    }
            }
        } else if constexpr (MODE == 4) {
            bf16_t* RES = (bf16_t*)a.o0; const float* st = (const float*)a.o1;
#pragma unroll
            for (int bj = 0; bj < 2; ++bj) {
                const int c = col0 + bj * HALF;
                const f32x4 g0 = *(const f32x4*)(a.p0 + c), g1 = *(const f32x4*)(a.p0 + c + 4), b0 = *(const f32x4*)(a.p1 + c), b1 = *(const f32x4*)(a.p1 + c + 4);
#pragma unroll
                for (int ai = 0; ai < 2; ++ai)
#pragma unroll
                    for (int m = 0; m < 4; ++m) { const int row = row0 + ai * HALF + m * 16; const f32x2 ms = *(const f32x2*)(st + 2 * (size_t)row);
                        bf16_t* p = RES + (size_t)row * D + c;
                        const u32x4 rw8 = *(const u32x4*)p;
                        const f32x4 r0 = (f32x4){bflo(rw8.x), bfhi(rw8.x), bflo(rw8.y), bfhi(rw8.y)}, r1 = (f32x4){bflo(rw8.z), bfhi(rw8.z), bflo(rw8.w), bfhi(rw8.w)};
                        const f32x4 o0 = ((r0 - ms.x) * ms.y * g0 + b0) * ALPHA + acc[ai][bj][m][0], o1 = ((r1 - ms.x) * ms.y * g1 + b1) * ALPHA + acc[ai][bj][m][1];
                        u32x4 w8; w8.x = cvt_pk_bf16(o0[0], o0[1]); w8.y = cvt_pk_bf16(o0[2], o0[3]); w8.z = cvt_pk_bf16(o1[0], o1[1]); w8.w = cvt_pk_bf16(o1[2], o1[3]);
                        *(u32x4*)p = w8; }
            }
        } else {
#pragma unroll
            for (int ai = 0; ai < 2; ++ai)
#pragma unroll
                for (int m = 0; m < 4; ++m) { const size_t off = (size_t)(row0 + ai * HALF + m * 16) * a.ldc + col0;
#pragma unroll
                    for (int bj = 0; bj < 2; ++bj) {
                        const f32x4 r0 = *(const f32x4*)(a.p0 + off + bj * HALF), r1 = *(const f32x4*)(a.p0 + off + bj * HALF + 4);
                        const f32x4 o0 = r0 * ALPHA + acc[ai][bj][m][0], o1 = r1 * ALPHA + acc[ai][bj][m][1];
                        u32x4 w8; w8.x = cvt_pk_bf16(o0[0], o0[1]); w8.y = cvt_pk_bf16(o0[2], o0[3]); w8.z = cvt_pk_bf16(o1[0], o1[1]); w8.w = cvt_pk_bf16(o1[2], o1[3]);
                        *(u32x4*)((bf16_t*)a.o0 + off + bj * HALF) = w8; }
                }
        }
    }
};
}

struct Args {
    const float* in[27];
    float* out;
    unsigned char* ws;
    int ph_lo, ph_hi;
};

struct Ctx { int tid, lane, wave, G, gw, NGW; };
__device__ __forceinline__ const float* arg_in(int k) {
    typedef const char __attribute__((address_space(4)))* kptr_t;
    kptr_t kp = (kptr_t)__builtin_amdgcn_kernarg_segment_ptr();
    asm volatile("" : "+s"(kp));
    return *(const float* const __attribute__((address_space(4)))*)(kp + 8 * k);
}
__device__ __forceinline__ float* arg_out() { return (float*)arg_in(27); }
__device__ __forceinline__ unsigned char* arg_ws() { return (unsigned char*)arg_in(28); }
__device__ __forceinline__ int arg_int(int byteoff) {
    typedef const char __attribute__((address_space(4)))* kptr_t;
    kptr_t kp = (kptr_t)__builtin_amdgcn_kernarg_segment_ptr();
    asm volatile("" : "+s"(kp));
    return *(const int __attribute__((address_space(4)))*)(kp + byteoff);
}
__device__ __forceinline__ int opaque_tid() { int t = threadIdx.x; asm volatile("" : "+v"(t)); return t; }
__device__ __forceinline__ Ctx mkctx() { Ctx C; C.tid = opaque_tid(); C.lane = C.tid & 63; C.wave = __builtin_amdgcn_readfirstlane(C.tid >> 6); C.G = gridDim.x;
    int b = blockIdx.x; asm volatile("" : "+s"(b)); C.gw = b * 8 + C.wave; C.NGW = C.G * 8; return C; }

__device__ __forceinline__ void transpose_item(const float* W, int K, int N, bf16_t* WT, LAS float* scr, int item, int lane) {
    const int nblk = N / 32, kb = item / nblk, nb = item % nblk, k0 = 64 * kb, n0 = 32 * nb;
#pragma unroll 8
    for (int i = 0; i < 32; ++i) { const int kk = 2 * i + (lane >> 5); scr[kk * 33 + (lane & 31)] = W[(size_t)(k0 + kk) * N + n0 + (lane & 31)]; }
    asm volatile("s_waitcnt lgkmcnt(0)" ::: "memory");
    const int c = lane & 7;
#pragma unroll
    for (int j = 0; j < 4; ++j) { const int n = (lane >> 3) + 8 * j; const LAS float* s = scr + (8 * c) * 33 + n;
        u32x4 o; o.x = cvt_pk_bf16(s[0 * 33], s[1 * 33]); o.y = cvt_pk_bf16(s[2 * 33], s[3 * 33]); o.z = cvt_pk_bf16(s[4 * 33], s[5 * 33]); o.w = cvt_pk_bf16(s[6 * 33], s[7 * 33]);
        *(u32x4*)(WT + (size_t)(n0 + n) * K + k0 + 8 * c) = o; }
    asm volatile("s_waitcnt lgkmcnt(0)" ::: "memory");
}
__device__ __forceinline__ void titem_issue(const float* W, int N, int item, int lane, float (&v)[32]) {
    const int nblk = N / 32, kb = item / nblk, nb = item % nblk, k0 = 64 * kb, n0 = 32 * nb;
#pragma unroll
    for (int i = 0; i < 32; ++i) { const int kk = 2 * i + (lane >> 5); v[i] = W[(size_t)(k0 + kk) * N + n0 + (lane & 31)]; }
}
__device__ __forceinline__ void titem_finish(int K, int N, bf16_t* WT, LAS float* scr, int item, int lane, int ffremap, const float (&v)[32]) {
    const int nblk = N / 32, kb = item / nblk, nb = item % nblk, k0 = 64 * kb, n0 = 32 * nb;
    int n0d = n0; if (ffremap) { const int hh = n0 / FF, cc = n0 - hh * FF; n0d = (cc >> 7) * 256 + hh * 128 + (cc & 127); }
#pragma unroll
    for (int i = 0; i < 32; ++i) { const int kk = 2 * i + (lane >> 5); scr[kk * 33 + (lane & 31)] = v[i]; }
    asm volatile("s_waitcnt lgkmcnt(0)" ::: "memory");
    const int c = lane & 7;
#pragma unroll
    for (int j = 0; j < 4; ++j) { const int n = (lane >> 3) + 8 * j; const LAS float* sp = scr + (8 * c) * 33 + n;
        u32x4 o; o.x = cvt_pk_bf16(sp[0 * 33], sp[1 * 33]); o.y = cvt_pk_bf16(sp[2 * 33], sp[3 * 33]); o.z = cvt_pk_bf16(sp[4 * 33], sp[5 * 33]); o.w = cvt_pk_bf16(sp[6 * 33], sp[7 * 33]);
        *(u32x4*)(WT + (size_t)(n0d + n) * K + k0 + 8 * c) = o; }
    asm volatile("s_waitcnt lgkmcnt(0)" ::: "memory");
}
__device__ __forceinline__ void transpose_item64(const float* W, int K, int N, bf16_t* WT, LAS float* scr, int item, int lane, int ffremap) {
    const int nblk = N / 64, kb = item / nblk, nb = item % nblk, k0 = 64 * kb, n0 = 64 * nb;
    int n0d = n0; if (ffremap) { const int hh = n0 / FF, cc = n0 - hh * FF; n0d = (cc >> 7) * 256 + hh * 128 + (cc & 127); }
    const int c4 = 4 * (lane & 15), kq = lane >> 4;
#pragma unroll 4
    for (int i = 0; i < 16; ++i) { const int kk = 4 * i + kq; const f32x4 v = *(const f32x4*)(W + (size_t)(k0 + kk) * N + n0 + c4);
        LAS float* d = scr + kk * 65 + c4; d[0] = v[0]; d[1] = v[1]; d[2] = v[2]; d[3] = v[3]; }
    asm volatile("s_waitcnt lgkmcnt(0)" ::: "memory");
    const int c = lane & 7;
#pragma unroll
    for (int j = 0; j < 8; ++j) { const int n = (lane >> 3) + 8 * j; const LAS float* sp = scr + (8 * c) * 65 + n;
        u32x4 o; o.x = cvt_pk_bf16(sp[0 * 65], sp[1 * 65]); o.y = cvt_pk_bf16(sp[2 * 65], sp[3 * 65]); o.z = cvt_pk_bf16(sp[4 * 65], sp[5 * 65]); o.w = cvt_pk_bf16(sp[6 * 65], sp[7 * 65]);
        *(u32x4*)(WT + (size_t)(n0d + n) * K + k0 + 8 * c) = o; }
    asm volatile("s_waitcnt lgkmcnt(0)" ::: "memory");
}
__device__ __forceinline__ void transpose_mat(const Ctx& C_unused, LAS unsigned char* lds, const float* W, int K, int N, bf16_t* WT, int ffremap = 0) {
    const Ctx C = mkctx();
    LAS float* scr = (LAS float*)(lds + C.wave * 16640);
    if (N % 64 == 0) {
        const int items = (K / 64) * (N / 64);
        for (int it = C.gw; it < items; it += C.NGW) transpose_item64(W, K, N, WT, scr, it, C.lane, ffremap);
    } else {
        const int items = (K / 64) * (N / 32);
        for (int it = C.gw; it < items; it += C.NGW) transpose_item(W, K, N, WT, scr, it, C.lane);
    }
}
__device__ __forceinline__ void transpose_pad96(const Ctx& C_unused, const float* W, bf16_t* WT) {
    const Ctx C = mkctx();
    const int gt = C.gw * 64 + C.lane, NT = C.NGW * 64;
    for (int idx = gt; idx < 2048 * 32; idx += NT) { const int n = idx & 2047, k8 = idx >> 11; u32x4 o = (u32x4){0u, 0u, 0u, 0u};
        if (k8 < 12) { float v[8];
#pragma unroll
            for (int j = 0; j < 8; ++j) v[j] = W[(size_t)(8 * k8 + j) * 2048 + n];
            o.x = cvt_pk_bf16(v[0], v[1]); o.y = cvt_pk_bf16(v[2], v[3]); o.z = cvt_pk_bf16(v[4], v[5]); o.w = cvt_pk_bf16(v[6], v[7]); }
        *(u32x4*)(WT + (size_t)n * 256 + 8 * k8) = o; }
}
__device__ __forceinline__ void zero_fill16(const Ctx& C_unused, void* p, size_t n16) {
    const Ctx C = mkctx();
    const size_t gt = (size_t)C.gw * 64 + C.lane, NT = (size_t)C.NGW * 64;
    for (size_t i = gt; i < n16; i += NT) ((u32x4*)p)[i] = (u32x4){0u, 0u, 0u, 0u};
}
__device__ __forceinline__ void mix_phase(const Ctx& C_unused, const float* x, const float* mu, int s0, int s1, int s2, bf16_t* XM) {
    const Ctx C = mkctx();
    const int gt = C.gw * 64 + C.lane, NT = C.NGW * 64;
    for (int idx = gt; idx < M * (D / 4); idx += NT) {
        const int t = idx >> 9, c4 = idx & 511;
        const f32x4 xv = ((const f32x4*)x)[idx];
        f32x4 xp = (f32x4){0.f, 0.f, 0.f, 0.f};
        if (t & (SEQ - 1)) xp = ((const f32x4*)x)[idx - 512];
        const f32x4 xx = xp - xv;
        const f32x4 m0 = ((const f32x4*)(mu + s0 * D))[c4], m1 = ((const f32x4*)(mu + s1 * D))[c4], m2 = ((const f32x4*)(mu + s2 * D))[c4];
        const f32x4 a = xv + xx * m0, b = xv + xx * m1, c = xv + xx * m2;
        u32x2 w;
        w.x = cvt_pk_bf16(a[0], a[1]); w.y = cvt_pk_bf16(a[2], a[3]); ((u32x2*)XM)[idx] = w;
        w.x = cvt_pk_bf16(b[0], b[1]); w.y = cvt_pk_bf16(b[2], b[3]); ((u32x2*)(XM + (size_t)M * D))[idx] = w;
        w.x = cvt_pk_bf16(c[0], c[1]); w.y = cvt_pk_bf16(c[2], c[3]); ((u32x2*)(XM + (size_t)2 * M * D))[idx] = w;
    }
}
__device__ __forceinline__ void ln_phase(const Ctx& C_unused, const bf16_t* src, const float* g, const float* b, float* of32, bf16_t* obf, float* stats) {
    const Ctx C = mkctx();
    u32x4 nx[4];
    if (C.gw < M) { const u32x4* xr = (const u32x4*)(src + (size_t)C.gw * D) + C.lane;
#pragma unroll
        for (int j = 0; j < 4; ++j) nx[j] = xr[64 * j]; }
    for (int m = C.gw; m < M; m += C.NGW) {
        f32x4 v[8]; float s = 0.f;
#pragma unroll
        for (int j = 0; j < 4; ++j) { v[2 * j] = (f32x4){bflo(nx[j].x), bfhi(nx[j].x), bflo(nx[j].y), bfhi(nx[j].y)}; v[2 * j + 1] = (f32x4){bflo(nx[j].z), bfhi(nx[j].z), bflo(nx[j].w), bfhi(nx[j].w)}; }
#pragma unroll
        for (int j = 0; j < 8; ++j) s += (v[j][0] + v[j][1]) + (v[j][2] + v[j][3]);
        if (m + C.NGW < M) { const u32x4* xr = (const u32x4*)(src + (size_t)(m + C.NGW) * D) + C.lane;
#pragma unroll
            for (int j = 0; j < 4; ++j) nx[j] = xr[64 * j]; }
        const float mean = wave_sum(s) * (1.f / D); float s2 = 0.f;
#pragma unroll
        for (int j = 0; j < 8; ++j) { v[j] = v[j] - mean; s2 += (v[j][0] * v[j][0] + v[j][1] * v[j][1]) + (v[j][2] * v[j][2] + v[j][3] * v[j][3]); }
        const float rstd = 1.0f / sqrtf(wave_sum(s2) * (1.f / D) + LN_EPS);
        if (stats && C.lane == 0) *(f32x2*)(stats + 2 * (size_t)m) = (f32x2){mean, rstd};
#pragma unroll
        for (int j = 0; j < 4; ++j) {
            const int ch = C.lane + 64 * j;
            const f32x4 ga = ((const f32x4*)g)[2 * ch], gb_ = ((const f32x4*)g)[2 * ch + 1], ba = ((const f32x4*)b)[2 * ch], bb = ((const f32x4*)b)[2 * ch + 1];
            const f32x4 o0 = v[2 * j] * rstd * ga + ba, o1 = v[2 * j + 1] * rstd * gb_ + bb;
            if (of32) { ((f32x4*)(of32 + (size_t)m * D))[2 * ch] = o0; ((f32x4*)(of32 + (size_t)m * D))[2 * ch + 1] = o1; }
            if (obf) { u32x4 w; w.x = cvt_pk_bf16(o0[0], o0[1]); w.y = cvt_pk_bf16(o0[2], o0[3]); w.z = cvt_pk_bf16(o1[0], o1[1]); w.w = cvt_pk_bf16(o1[2], o1[3]); ((u32x4*)(obf + (size_t)m * D))[ch] = w; }
        }
    }
}
__device__ __forceinline__ void convact_phase(const Ctx& C_unused, bf16_t* HF, const float* cw, const float* cb) {
    const Ctx C = mkctx();
    constexpr int TT = 32, NCB = FF / 512;
    const int nitems = (M / TT) * NCB;
    for (int it = C.gw; it < nitems; it += C.NGW) {
        const int cbk = it % NCB, tt = it / NCB, t0 = tt * TT, c0 = cbk * 512 + C.lane * 8;
        float w0[8], w1[8], w2[8], bs[8], g2[8], g1[8];
#pragma unroll
        for (int j = 0; j < 8; ++j) { w0[j] = cw[c0 + j]; w1[j] = cw[FF + c0 + j]; w2[j] = cw[2 * FF + c0 + j]; bs[j] = cb[c0 + j]; g2[j] = 0.f; g1[j] = 0.f; }
        if (t0 & (SEQ - 1)) {
            const u32x4 a = *(const u32x4*)(HF + (size_t)(t0 - 2) * FF2 + c0), b = *(const u32x4*)(HF + (size_t)(t0 - 1) * FF2 + c0);
            g2[0] = bflo(a.x); g2[1] = bfhi(a.x); g2[2] = bflo(a.y); g2[3] = bfhi(a.y); g2[4] = bflo(a.z); g2[5] = bfhi(a.z); g2[6] = bflo(a.w); g2[7] = bfhi(a.w);
            g1[0] = bflo(b.x); g1[1] = bfhi(b.x); g1[2] = bflo(b.y); g1[3] = bfhi(b.y); g1[4] = bflo(b.z); g1[5] = bfhi(b.z); g1[6] = bflo(b.w); g1[7] = bfhi(b.w);
        }
#pragma unroll 4
        for (int t = t0; t < t0 + TT; ++t) {
            const u32x4 gv = *(const u32x4*)(HF + (size_t)t * FF2 + c0), uv = *(const u32x4*)(HF + (size_t)t * FF2 + FF + c0);
            float g0[8], up[8], o[8];
            g0[0] = bflo(gv.x); g0[1] = bfhi(gv.x); g0[2] = bflo(gv.y); g0[3] = bfhi(gv.y); g0[4] = bflo(gv.z); g0[5] = bfhi(gv.z); g0[6] = bflo(gv.w); g0[7] = bfhi(gv.w);
            up[0] = bflo(uv.x); up[1] = bfhi(uv.x); up[2] = bflo(uv.y); up[3] = bfhi(uv.y); up[4] = bflo(uv.z); up[5] = bfhi(uv.z); up[6] = bflo(uv.w); up[7] = bfhi(uv.w);
#pragma unroll
            for (int j = 0; j < 8; ++j) { const float a = bs[j] + g2[j] * w0[j] + g1[j] * w1[j] + g0[j] * w2[j]; o[j] = a * sigmoidf_(a) * up[j]; g2[j] = g1[j]; g1[j] = g0[j]; }
            u32x4 w; w.x = cvt_pk_bf16(o[0], o[1]); w.y = cvt_pk_bf16(o[2], o[3]); w.z = cvt_pk_bf16(o[4], o[5]); w.w = cvt_pk_bf16(o[6], o[7]);
            *(u32x4*)(HF + (size_t)t * FF2 + FF + c0) = w;
        }
    }
}

__device__ __forceinline__ void convfix_phase(const Ctx& C_unused, bf16_t* ACT, const float* GS, const float* US, const float* cw, const float* cb) {
    const Ctx C = mkctx();
    const int gt = C.gw * 64 + C.lane, NT = C.NGW * 64;
    constexpr int C4 = FF / 4;
    for (int idx = gt; idx < 256 * 2 * C4; idx += NT) {
        const int c = 4 * (idx % C4), rr = (idx / C4) & 1, g = idx / (2 * C4);
        const bool first = (g & 63) == 0;
        const f32x4 z = (f32x4){0.f, 0.f, 0.f, 0.f};
        const f32x4 g0 = *(const f32x4*)(GS + ((size_t)g * 4 + rr) * FF + c);
        f32x4 g1, g2;
        if (rr == 0) { g1 = first ? z : *(const f32x4*)(GS + ((size_t)(g - 1) * 4 + 3) * FF + c); g2 = first ? z : *(const f32x4*)(GS + ((size_t)(g - 1) * 4 + 2) * FF + c); }
        else { g1 = *(const f32x4*)(GS + ((size_t)g * 4 + 0) * FF + c); g2 = first ? z : *(const f32x4*)(GS + ((size_t)(g - 1) * 4 + 3) * FF + c); }
        const f32x4 up = *(const f32x4*)(US + ((size_t)g * 2 + rr) * FF + c);
        const f32x4 w0 = *(const f32x4*)(cw + c), w1 = *(const f32x4*)(cw + FF + c), w2 = *(const f32x4*)(cw + 2 * FF + c), bs = *(const f32x4*)(cb + c);
        const f32x4 av = bs + w0 * g2 + w1 * g1 + w2 * g0;
        f32x4 o;
#pragma unroll
        for (int j = 0; j < 4; ++j) o[j] = av[j] * sigmoidf_(av[j]) * up[j];
        u32x2 w; w.x = cvt_pk_bf16(o[0], o[1]); w.y = cvt_pk_bf16(o[2], o[3]);
        *(u32x2*)(ACT + ((size_t)g * 64 + rr) * FF + c) = w;
    }
}

constexpr int TC = 32, SROW = 360;
struct ScanP { const bf16_t* R; const bf16_t* K; const bf16_t* V; const bf16_t* AA; const bf16_t* DEC; const float* k_k; const float* k_a; const float* r_k; bf16_t* Y; float* BONUS;
               const float* t_up; const float* t_dn; const float* t_wo; bf16_t* d_up; bf16_t* d_dn; bf16_t* d_wo;
               const float* t_up0; const float* t_dn0; const float* t_wo0; bf16_t* d_up0; bf16_t* d_dn0; bf16_t* d_wo0; };
constexpr int TW_I0 = (D / 64) * (FF2 / 32), TW_I1 = (FF / 64) * (D / 32), TW_I2 = (D / 64) * (D / 32), TW_HALF = TW_I0 + TW_I1 + TW_I2, TW_TOTAL = 2 * TW_HALF;
#define TW_DECODE(P, ti, SRC, DST, KK, NN, IT, RM) const bool l1_ = (ti) >= TW_HALF; const int t_ = l1_ ? (ti) - TW_HALF : (ti); \
    const int sg_ = (t_ < TW_I0) ? 0 : ((t_ < TW_I0 + TW_I1) ? 1 : 2); \
    const float* SRC = sg_ == 0 ? (l1_ ? (P).t_up : (P).t_up0) : (sg_ == 1 ? (l1_ ? (P).t_dn : (P).t_dn0) : (l1_ ? (P).t_wo : (P).t_wo0)); \
    bf16_t* DST = sg_ == 0 ? (l1_ ? (P).d_up : (P).d_up0) : (sg_ == 1 ? (l1_ ? (P).d_dn : (P).d_dn0) : (l1_ ? (P).d_wo : (P).d_wo0)); \
    const int KK = sg_ == 1 ? FF : D, NN = sg_ == 0 ? FF2 : D, IT = sg_ == 0 ? t_ : (sg_ == 1 ? t_ - TW_I0 : t_ - TW_I0 - TW_I1), RM = sg_ == 0 ? 1 : 0;
#define SCAN_LOADRAW(RR, KR, AR, DR, VR, tok_) do { const size_t t__ = (tok_); \
    RR = *(const u32x2*)(P.R + t__ * D + col); KR = *(const u32x2*)(P.K + t__ * D + col); AR = *(const u32x2*)(P.AA + t__ * D + col); \
    DR = *(const u32x2*)(P.DEC + t__ * D + col); VR = *(const unsigned*)(P.V + t__ * D + h * 64 + half * 32 + 2 * cl); } while (0)
#define SCAN_PREP(RR, KR, AR, DR, VR, tok_, buf_, step_) do { const size_t t__ = (tok_); \
    const f32x4 r = (f32x4){bflo(RR.x), bfhi(RR.x), bflo(RR.y), bfhi(RR.y)}; \
    const f32x4 k = (f32x4){bflo(KR.x), bfhi(KR.x), bflo(KR.y), bfhi(KR.y)}; \
    const f32x4 a = (f32x4){bflo(AR.x), bfhi(AR.x), bflo(AR.y), bfhi(AR.y)}; \
    const f32x4 dcy = (f32x4){__expf(bflo(DR.x)), __expf(bfhi(DR.x)), __expf(bflo(DR.y)), __expf(bfhi(DR.y))}; \
    const f32x4 kkr = k * kk4; \
    const float ss = red16((kkr[0] * kkr[0] + kkr[1] * kkr[1]) + (kkr[2] * kkr[2] + kkr[3] * kkr[3])); \
    const float inv = 1.0f / sqrtf(fmaxf(ss, 1e-24f)); \
    const f32x4 kk = kkr * inv; \
    const f32x4 kp = k * (1.0f + (a - 1.0f) * ka4); \
    const f32x4 bv = kk * a; \
    const float bon = red16((r[0] * kp[0] * rk4[0] + r[1] * kp[1] * rk4[1]) + (r[2] * kp[2] * rk4[2] + r[3] * kp[3] * rk4[3])); \
    LAS float* rec = inb + (buf_) * (TC * SROW) + (step_) * SROW; \
    *(LAS f32x4*)(rec + 4 * cl) = dcy; *(LAS f32x4*)(rec + 64 + 4 * cl) = -kk; *(LAS f32x4*)(rec + 128 + 4 * cl) = bv; \
    *(LAS f32x4*)(rec + 192 + 4 * cl) = kp; *(LAS f32x4*)(rec + 256 + 4 * cl) = r; \
    *(LAS f32x2*)(rec + 320 + 2 * cl) = (f32x2){bflo(VR), bfhi(VR)}; \
    if (cl == 0 && half == 0) P.BONUS[t__ * 32 + h] = bon; } while (0)
__device__ __forceinline__ void scan_phase(const ScanP P, LAS unsigned char* lds, int G) {
    LAS float* inb = (LAS float*)lds;
    LAS float* ybuf = (LAS float*)(lds + 2 * TC * SROW * 4);
    const int tid = opaque_tid();
    const bool helper = tid >= 256;
    const int ht = tid & 255, cl = ht & 15, hrw = ht >> 4;
    const int c8 = tid & 7, r8 = (tid >> 3) & 31;
    for (int item = blockIdx.x; item < 256; item += G) {
        const int bh = item >> 1, half = item & 1, bt = bh >> 5, h = bh & 31;
        const int col = h * 64 + 4 * cl;
        const size_t tok0 = (size_t)bt * SEQ;
        f32x4 kk4 = (f32x4){0.f, 0.f, 0.f, 0.f}, ka4 = kk4, rk4 = kk4;
        u32x2 rA_ = (u32x2){0u, 0u}, kA_ = rA_, aA_ = rA_, rB_ = rA_, kB_ = rA_, aB_ = rA_, dA_ = rA_, dB_ = rA_; unsigned vA_ = 0u, vB_ = 0u;
        float tv[32]; int tpend = -1;
#pragma unroll
        for (int i = 0; i < 32; ++i) tv[i] = 0.f;
        if (helper) {
            kk4 = *(const f32x4*)(P.k_k + col); ka4 = *(const f32x4*)(P.k_a + col); rk4 = *(const f32x4*)(P.r_k + col);
            SCAN_LOADRAW(rA_, kA_, aA_, dA_, vA_, tok0 + hrw); SCAN_LOADRAW(rB_, kB_, aB_, dB_, vB_, tok0 + hrw + 16);
            SCAN_PREP(rA_, kA_, aA_, dA_, vA_, tok0 + hrw, 0, hrw); SCAN_PREP(rB_, kB_, aB_, dB_, vB_, tok0 + hrw + 16, 0, hrw + 16);
            SCAN_LOADRAW(rA_, kA_, aA_, dA_, vA_, tok0 + TC + hrw); SCAN_LOADRAW(rB_, kB_, aB_, dB_, vB_, tok0 + TC + hrw + 16);
        }
        f32x2 S01 = (f32x2){0.f, 0.f}, S23 = (f32x2){0.f, 0.f}, S45 = (f32x2){0.f, 0.f}, S67 = (f32x2){0.f, 0.f};
        __syncthreads();
        for (int c = 0; c < SEQ / TC; ++c) {
            const int buf = c & 1;
            if (helper) {
                if (c > 0) {
                    const int tt = ht >> 3, rq = ht & 7;
                    const f32x4 yv = *(const LAS f32x4*)(ybuf + (buf ^ 1) * (TC * 32) + tt * 32 + 4 * rq);
                    u32x2 yw; yw.x = cvt_pk_bf16(yv[0], yv[1]); yw.y = cvt_pk_bf16(yv[2], yv[3]);
                    *(u32x2*)(P.Y + (tok0 + (c - 1) * TC + tt) * D + h * 64 + half * 32 + 4 * rq) = yw;
                }
                if (c + 1 < SEQ / TC) {
                    SCAN_PREP(rA_, kA_, aA_, dA_, vA_, tok0 + (c + 1) * TC + hrw, buf ^ 1, hrw); SCAN_PREP(rB_, kB_, aB_, dB_, vB_, tok0 + (c + 1) * TC + hrw + 16, buf ^ 1, hrw + 16);
                    if (c + 2 < SEQ / TC) { SCAN_LOADRAW(rA_, kA_, aA_, dA_, vA_, tok0 + (c + 2) * TC + hrw); SCAN_LOADRAW(rB_, kB_, aB_, dB_, vB_, tok0 + (c + 2) * TC + hrw + 16); }
                }
                LAS float* scr = (LAS float*)(lds + 2 * TC * SROW * 4 + 2 * TC * 32 * 4 + ((tid >> 6) - 4) * 8448);
                const int ln = tid & 63;
                if (tpend >= 0) { TW_DECODE(P, tpend, src_, dst_, kk_, nn_, it_, rm_); (void)src_; titem_finish(kk_, nn_, dst_, scr, it_, ln, rm_, tv); }
                const int q = ((item - (int)blockIdx.x) / G) * (SEQ / TC) + c;
                const int ti = q * (G * 4) + (int)blockIdx.x * 4 + ((tid >> 6) - 4);
                tpend = -1;
                if (ti < TW_TOTAL) { tpend = ti; TW_DECODE(P, ti, src_, dst_, kk_, nn_, it_, rm_); (void)dst_; (void)kk_; (void)rm_; titem_issue(src_, nn_, it_, ln, tv); }
            } else {
                const LAS float* rb = inb + buf * (TC * SROW) + 8 * c8;
                const LAS float* vb = inb + buf * (TC * SROW) + 320 + r8;
                LAS float* yb = ybuf + buf * (TC * 32) + r8;
                f32x4 wA = *(const LAS f32x4*)(rb), wB = *(const LAS f32x4*)(rb + 4), nA = *(const LAS f32x4*)(rb + 64), nB = *(const LAS f32x4*)(rb + 68);
                f32x4 bA = *(const LAS f32x4*)(rb + 128), bB = *(const LAS f32x4*)(rb + 132), kA = *(const LAS f32x4*)(rb + 192), kB = *(const LAS f32x4*)(rb + 196);
                f32x4 rA = *(const LAS f32x4*)(rb + 256), rB = *(const LAS f32x4*)(rb + 260);
                float vv = vb[0];
                float ykeep = 0.f; float qa[8];
                const bool b0 = (c8 & 1) != 0, b1 = (c8 & 2) != 0, b2 = (c8 & 4) != 0;
#pragma unroll
                for (int tt = 0; tt < TC; ++tt) {
                    f32x4 wAn = wA, wBn = wB, nAn = nA, nBn = nB, bAn = bA, bBn = bB, kAn = kA, kBn = kB, rAn = rA, rBn = rB; float vvn = vv;
                    if (tt + 1 < TC) { const LAS float* rn = rb + (tt + 1) * SROW;
                        wAn = *(const LAS f32x4*)(rn); wBn = *(const LAS f32x4*)(rn + 4); nAn = *(const LAS f32x4*)(rn + 64); nBn = *(const LAS f32x4*)(rn + 68);
                        bAn = *(const LAS f32x4*)(rn + 128); bBn = *(const LAS f32x4*)(rn + 132); kAn = *(const LAS f32x4*)(rn + 192); kBn = *(const LAS f32x4*)(rn + 196);
                        rAn = *(const LAS f32x4*)(rn + 256); rBn = *(const LAS f32x4*)(rn + 260); vvn = vb[(tt + 1) * SROW]; }
                    __builtin_amdgcn_sched_barrier(0);
                    f32x2 p = S01 * nA.lo, p2 = S45 * nB.lo; p = S23 * nA.hi + p; p2 = S67 * nB.hi + p2; p = p + p2;
                    const float sa = red8(p.x + p.y);
                    f32x2 t01 = kA.lo * vv, t23 = kA.hi * vv, t45 = kB.lo * vv, t67 = kB.hi * vv;
                    t01 = bA.lo * sa + t01; t23 = bA.hi * sa + t23; t45 = bB.lo * sa + t45; t67 = bB.hi * sa + t67;
                    S01 = S01 * wA.lo + t01; S23 = S23 * wA.hi + t23; S45 = S45 * wB.lo + t45; S67 = S67 * wB.hi + t67;
                    f32x2 q = S01 * rA.lo, q2 = S45 * rB.lo; q = S23 * rA.hi + q; q2 = S67 * rB.hi + q2; q = q + q2;
                    qa[tt & 7] = q.x + q.y;
                    if ((tt & 7) == 7) {
                        float r4[4], r2[2];
#pragma unroll
                        for (int i = 0; i < 4; ++i) { const float keep = b0 ? qa[2 * i + 1] : qa[2 * i], send = b0 ? qa[2 * i] : qa[2 * i + 1]; r4[i] = keep + dppf<0xB1>(send); }
#pragma unroll
                        for (int i = 0; i < 2; ++i) { const float keep = b1 ? r4[2 * i + 1] : r4[2 * i], send = b1 ? r4[2 * i] : r4[2 * i + 1]; r2[i] = keep + dppf<0x4E>(send); }
                        const float keep = b2 ? r2[1] : r2[0], send = b2 ? r2[0] : r2[1];
                        ykeep = keep + __shfl_xor(send, 4);
                        yb[(tt - 7 + c8) * 32] = ykeep;
                    }
                    __builtin_amdgcn_sched_barrier(0);
                    wA = wAn; wB = wBn; nA = nAn; nB = nBn; bA = bAn; bB = bBn; kA = kAn; kB = kBn; rA = rAn; rB = rBn; vv = vvn;
                }
            }
            __syncthreads();
        }
        if (helper) {
            {   const int c = SEQ / TC - 1, tt = ht >> 3, rq = ht & 7;
                const f32x4 yv = *(const LAS f32x4*)(ybuf + (c & 1) * (TC * 32) + tt * 32 + 4 * rq);
                u32x2 yw; yw.x = cvt_pk_bf16(yv[0], yv[1]); yw.y = cvt_pk_bf16(yv[2], yv[3]);
                *(u32x2*)(P.Y + (tok0 + c * TC + tt) * D + h * 64 + half * 32 + 4 * rq) = yw; }
            if (tpend >= 0) {
                LAS float* scr = (LAS float*)(lds + 2 * TC * SROW * 4 + 2 * TC * 32 * 4 + ((tid >> 6) - 4) * 8448);
                const int ln = tid & 63;
                TW_DECODE(P, tpend, src_, dst_, kk_, nn_, it_, rm_); (void)src_; titem_finish(kk_, nn_, dst_, scr, it_, ln, rm_, tv);
            }
        }
        __syncthreads();
    }
}
#undef SCAN_LOADRAW
#undef SCAN_PREP
__device__ __forceinline__ void post_phase(const Ctx& C_unused, const bf16_t* Y, const bf16_t* V, const bf16_t* Gt, const float* BONUS, const float* gn_g, const float* gn_b, bf16_t* YG) {
    const Ctx C = mkctx();
    const int gt = C.gw * 64 + C.lane, NT = C.NGW * 64;
    for (int idx = gt; idx < M * (D / 4); idx += NT) {
        const int t = idx >> 9, c4 = idx & 511, h = c4 >> 4;
        const u32x2 yr = ((const u32x2*)Y)[idx];
        const f32x4 y = (f32x4){bflo(yr.x), bfhi(yr.x), bflo(yr.y), bfhi(yr.y)};
        const float mean = red16((y[0] + y[1]) + (y[2] + y[3])) * (1.f / 64.f);
        const f32x4 dlt = y - mean;
        const float var = red16((dlt[0] * dlt[0] + dlt[1] * dlt[1]) + (dlt[2] * dlt[2] + dlt[3] * dlt[3])) * (1.f / 64.f);
        const float rstd = 1.0f / sqrtf(var + GN_EPS);
        const f32x4 gg = ((const f32x4*)gn_g)[c4], gb = ((const f32x4*)gn_b)[c4];
        const u32x2 vr = ((const u32x2*)V)[idx], gr = ((const u32x2*)Gt)[idx];
        const f32x4 v = (f32x4){bflo(vr.x), bfhi(vr.x), bflo(vr.y), bfhi(vr.y)}, gate = (f32x4){bflo(gr.x), bfhi(gr.x), bflo(gr.y), bfhi(gr.y)};
        const float bon = BONUS[(size_t)t * 32 + h];
        const f32x4 o = (dlt * rstd * gg + gb + v * bon) * gate;
        u32x2 w; w.x = cvt_pk_bf16(o[0], o[1]); w.y = cvt_pk_bf16(o[2], o[3]); ((u32x2*)YG)[idx] = w;
    }
}

constexpr int KROWB = 272;
constexpr int VT_OFF = 256 * KROWB;
__device__ __forceinline__ void attn_phase(const bf16_t* QKV, bf16_t* OG, float* LSE, int dil, LAS unsigned char* lds, int G, int accum) {
    const int tid = opaque_tid(), lane = tid & 63, wave0 = __builtin_amdgcn_readfirstlane(tid >> 6), fr = lane & 15, fq = lane >> 4;
    const int nb = 32 / dil, RL = nb < 4 ? nb : 4, rpc = nb / RL, nitems = 2048 / RL;
    const int krow = tid >> 4, kch = tid & 15;
    const int vdch = tid >> 5, vkq = tid & 31;
    for (int item = blockIdx.x; item < nitems; item += G) {
        int wave = wave0; asm volatile("" : "+v"(wave));
        const int chain = item / rpc, run = item - chain * rpc;
        const int r = chain % dil, h = (chain / dil) & 15, bt = chain / (dil * 16);
        const int n0 = run * RL;
        const size_t tok0 = (size_t)bt * SEQ;
        const bf16_t* kbase = QKV + 2048 + h * 128 + kch * 8;
        const bf16_t* vbase = QKV + 4096 + h * 128 + vdch * 8;
        u32x4 kreg[4], vreg[4]; bf16x8 qn[4];
#define AT_LOAD(nn) do { _Pragma("unroll") for (int it = 0; it < 4; ++it) { const int pos = ((nn) * 128 + krow + 32 * it) * dil + r; kreg[it] = *(const u32x4*)(kbase + (tok0 + pos) * NQKV); } \
        _Pragma("unroll") for (int j = 0; j < 4; ++j) { const int pos = ((nn) * 128 + 4 * vkq + j) * dil + r; vreg[j] = *(const u32x4*)(vbase + (tok0 + pos) * NQKV); } } while (0)
#define AT_STORE(slot) do { _Pragma("unroll") for (int it = 0; it < 4; ++it) *(LAS u32x4*)(lds + ((slot) * 128 + krow + 32 * it) * KROWB + kch * 16) = kreg[it]; \
        _Pragma("unroll") for (int i = 0; i < 8; ++i) { unsigned e0, e1, e2, e3; \
            if (i & 1) { e0 = vreg[0][i >> 1] >> 16; e1 = vreg[1][i >> 1] >> 16; e2 = vreg[2][i >> 1] >> 16; e3 = vreg[3][i >> 1] >> 16; } \
            else { e0 = vreg[0][i >> 1] & 0xffffu; e1 = vreg[1][i >> 1] & 0xffffu; e2 = vreg[2][i >> 1] & 0xffffu; e3 = vreg[3][i >> 1] & 0xffffu; } \
            u32x2 w_; w_.x = e0 | (e1 << 16); w_.y = e2 | (e3 << 16); \
            *(LAS u32x2*)(lds + VT_OFF + (8 * vdch + i) * 512 + ((((slot) * 32 + vkq) ^ (4 * i)) * 8)) = w_; } } while (0)
#define AT_LOADQ(nn) do { const size_t qt_ = tok0 + (size_t)(((nn) * 128 + 16 * wave + fr) * dil + r); \
        _Pragma("unroll") for (int ks = 0; ks < 4; ++ks) qn[ks] = *(const bf16x8*)(QKV + qt_ * NQKV + h * 128 + 32 * ks + 8 * fq); } while (0)
        if (n0 > 0) { AT_LOAD(n0 - 1); }
        else {
#pragma unroll
            for (int j = 0; j < 4; ++j) { kreg[j] = (u32x4){0u, 0u, 0u, 0u}; vreg[j] = (u32x4){0u, 0u, 0u, 0u}; } }
        AT_STORE((n0 & 1) ^ 1);
        AT_LOAD(n0); AT_LOADQ(n0);
        for (int n = n0; n < n0 + RL; ++n) {
            asm volatile("" : "+v"(wave));
            AT_STORE(n & 1);
            bf16x8 qf[4];
#pragma unroll
            for (int ks = 0; ks < 4; ++ks) qf[ks] = qn[ks];
            __syncthreads();
            if (n + 1 < n0 + RL) { AT_LOAD(n + 1); AT_LOADQ(n + 1); }
            const int flip = (n & 1) ^ 1;
            const int qi = 16 * wave + fr;
            const size_t qtok = tok0 + (size_t)((n * 128 + qi) * dil + r);
            f32x4 sc[10];
#pragma unroll
            for (int tt = 0; tt < 10; ++tt) {
                const int tile = ((wave + tt) < 15 ? (wave + tt) : 15) ^ (8 * flip);
                f32x4 acc = (f32x4){0.f, 0.f, 0.f, 0.f};
#pragma unroll
                for (int ks = 0; ks < 4; ++ks) {
                    const bf16x8 kf = *(const LAS bf16x8*)(lds + (16 * tile + fr) * KROWB + 64 * ks + 16 * fq);
                    acc = __builtin_amdgcn_mfma_f32_16x16x32_bf16(kf, qf[ks], acc, 0, 0, 0);
                }
                sc[tt] = acc;
            }
            constexpr float SC2 = 0.08838834764831845f * 1.4426950408889634f;
            float mx = -3.0e38f;
#pragma unroll
            for (int tt = 0; tt < 10; ++tt) {
                const bool tile_ok = (wave + tt <= 15) && (n > 0 || (wave + tt) >= 8);
#pragma unroll
                for (int j = 0; j < 4; ++j) {
                    bool valid = tile_ok;
                    if (tt == 0 || tt >= 8) { const int kj = 16 * (wave + tt) + 4 * fq + j; valid = valid && (kj >= qi) && (kj <= qi + 128); }
                    const float s = valid ? sc[tt][j] * SC2 : -1e30f;
                    sc[tt][j] = s; mx = fmaxf(mx, s);
                }
            }
            mx = fmaxf(mx, __shfl_xor(mx, 16)); mx = fmaxf(mx, __shfl_xor(mx, 32));
            float sum = 0.f;
#pragma unroll
            for (int tt = 0; tt < 10; ++tt)
#pragma unroll
                for (int j = 0; j < 4; ++j) { const float p = __builtin_amdgcn_exp2f(sc[tt][j] - mx); sc[tt][j] = p; sum += p; }
            sum += __shfl_xor(sum, 16); sum += __shfl_xor(sum, 32);
            bf16x8 pf[5];
#pragma unroll
            for (int s = 0; s < 5; ++s) {
                u32x4 w; w.x = cvt_pk_bf16(sc[2 * s][0], sc[2 * s][1]); w.y = cvt_pk_bf16(sc[2 * s][2], sc[2 * s][3]);
                w.z = cvt_pk_bf16(sc[2 * s + 1][0], sc[2 * s + 1][1]); w.w = cvt_pk_bf16(sc[2 * s + 1][2], sc[2 * s + 1][3]);
                pf[s] = __builtin_bit_cast(bf16x8, w);
            }
            const float inv = 1.0f / sum;
            bf16_t* orow = OG + qtok * D + h * 128 + 4 * fq;
            const float lse_g = (mx + __builtin_amdgcn_logf(sum)) * 0.6931471805599453f;
            float w_old = 0.f, w_new = inv, lse_out = lse_g;
            u32x2 oldv[8];
            if (accum) {
#pragma unroll
                for (int dt = 0; dt < 8; ++dt) oldv[dt] = *(const u32x2*)(orow + 16 * dt);
                const float lse_o = LSE[qtok * 16 + h];
                const float mxl = fmaxf(lse_o, lse_g), eo = __expf(lse_o - mxl), en = __expf(lse_g - mxl), rden = 1.0f / (eo + en);
                w_old = eo * rden; w_new = en * rden * inv; lse_out = mxl + __logf(eo + en);
            }
#pragma unroll
            for (int dt = 0; dt < 8; ++dt) {
                f32x4 o = (f32x4){0.f, 0.f, 0.f, 0.f};
                const LAS unsigned char* vrow = lds + VT_OFF + (16 * dt + fr) * 512;
                const int sw = 4 * (fr & 7);
#pragma unroll
                for (int s = 0; s < 5; ++s) {
                    const int tA = ((wave + 2 * s) < 15 ? (wave + 2 * s) : 15) ^ (8 * flip), tB = ((wave + 2 * s + 1) < 15 ? (wave + 2 * s + 1) : 15) ^ (8 * flip);
                    const u32x2 va = *(const LAS u32x2*)(vrow + (((4 * tA + fq) ^ sw) * 8)), vb = *(const LAS u32x2*)(vrow + (((4 * tB + fq) ^ sw) * 8));
                    const u32x4 vv = (u32x4){va.x, va.y, vb.x, vb.y};
                    o = __builtin_amdgcn_mfma_f32_16x16x32_bf16(__builtin_bit_cast(bf16x8, vv), pf[s], o, 0, 0, 0);
                }
                f32x4 r = o * w_new;
                if (accum) r = r + (f32x4){bflo(oldv[dt].x), bfhi(oldv[dt].x), bflo(oldv[dt].y), bfhi(oldv[dt].y)} * w_old;
                u32x2 w; w.x = cvt_pk_bf16(r[0], r[1]); w.y = cvt_pk_bf16(r[2], r[3]);
                *(u32x2*)(orow + 16 * dt) = w;
            }
            if (fq == 0) LSE[qtok * 16 + h] = lse_out;
            __syncthreads();
        }
#undef AT_LOAD
#undef AT_STORE
#undef AT_LOADQ
    }
}
__device__ __forceinline__ void merge_phase(const Ctx& C_unused, const bf16_t* OG, const float* LSE, bf16_t* OM) {
    const Ctx C = mkctx();
    const int gt = C.gw * 64 + C.lane, NT = C.NGW * 64;
    for (int idx = gt; idx < M * (D / 8); idx += NT) {
        const int t = idx >> 8, c8 = idx & 255, h = c8 >> 4;
        const float l0 = LSE[(size_t)t * 16 + h], l1 = LSE[(size_t)(M + t) * 16 + h], l2 = LSE[(size_t)(2 * M + t) * 16 + h];
        const float mx = fmaxf(l0, fmaxf(l1, l2));
        float w0 = __expf(l0 - mx), w1 = __expf(l1 - mx), w2 = __expf(l2 - mx);
        const float inv = 1.0f / (w0 + w1 + w2); w0 *= inv; w1 *= inv; w2 *= inv;
        const u32x4 a = ((const u32x4*)OG)[idx], b = ((const u32x4*)(OG + (size_t)M * D))[idx], c = ((const u32x4*)(OG + (size_t)2 * M * D))[idx];
        u32x4 o;
#pragma unroll
        for (int j = 0; j < 4; ++j) {
            const float lo = w0 * bflo(a[j]) + w1 * bflo(b[j]) + w2 * bflo(c[j]);
            const float hi = w0 * bfhi(a[j]) + w1 * bfhi(b[j]) + w2 * bfhi(c[j]);
            o[j] = cvt_pk_bf16(lo, hi);
        }
        ((u32x4*)OM)[idx] = o;
    }
}

#define XB_TMO      128
#define XB_XCNT(j)  (256  + 64 * (j))
#define XB_XSUB(j)  (1280 + 64 * (j))
#define XB_XGEN(j)  (2304 + 64 * (j))
#define XB_TOP      3328
#define XB_TOPGEN   3392
#define XCD_BAR_WORDS 3456
#define XB_SPIN_CAP (1u << 18)
constexpr size_t O_BAR = 512 * 1024;
__device__ __forceinline__ unsigned xb_ld(unsigned* p)              { return __hip_atomic_load(p, __ATOMIC_RELAXED, __HIP_MEMORY_SCOPE_AGENT); }
__device__ __forceinline__ unsigned xb_add(unsigned* p, unsigned v) { return __hip_atomic_fetch_add(p, v, __ATOMIC_RELAXED, __HIP_MEMORY_SCOPE_AGENT); }
__device__ __forceinline__ unsigned xb_xcc_id() { return (unsigned)__builtin_amdgcn_s_getreg((3 << 11) | 20) & 0xFu; }
#define XB_SPIN(cond, bar) do { unsigned _sp = 0; while (cond) { __builtin_amdgcn_s_sleep(1); \
    if ((++_sp & 255u) == 0u) { if (xb_ld(&(bar)[XB_TMO])) break; if (_sp > XB_SPIN_CAP) { atomicAdd(&(bar)[XB_TMO], 1u); break; } } } } while (0)
struct XcdBarrier { unsigned* bar; unsigned x; volatile LAS unsigned* st; };
__device__ __forceinline__ XcdBarrier xcd_barrier_post(unsigned* bar, volatile LAS unsigned* st) {
    XcdBarrier b; b.bar = bar; b.x = xb_xcc_id(); b.st = st;
    if (threadIdx.x == 0) (void)xb_add(&bar[XB_XCNT(b.x)], 1u);
    return b;
}
__device__ __forceinline__ void xcd_barrier_complete(unsigned* bar, unsigned x, unsigned& nloc, unsigned& nx) {
    const unsigned G = gridDim.x * gridDim.y * gridDim.z;
    unsigned sum, cnt, mine, sp = 0u;
    for (;;) {
        sum = 0u; cnt = 0u; mine = 0u;
#pragma unroll
        for (unsigned j = 0; j < 16; ++j) { const unsigned c = xb_ld(&bar[XB_XCNT(j)]); sum += c; cnt += (c > 0u) ? 1u : 0u; mine = (j == x) ? c : mine; }
        if (sum == G) break;
        __builtin_amdgcn_s_sleep(1);
        if ((++sp & 255u) == 0u) { if (xb_ld(&bar[XB_TMO])) break; if (sp > XB_SPIN_CAP) { atomicAdd(&bar[XB_TMO], 1u); break; } }
    }
    nloc = mine > 0u ? mine : 1u; nx = cnt > 0u ? cnt : 1u;
}
__device__ __forceinline__ void xcd_barrier(const XcdBarrier& b) {
    asm volatile("s_waitcnt vmcnt(0)" ::: "memory");
    __syncthreads();
    if (threadIdx.x == 0) {
        unsigned* bar = b.bar;
        __builtin_amdgcn_s_waitcnt(0);
        unsigned nloc = b.st[0], nx = b.st[1];
        if (nloc == 0u) { xcd_barrier_complete(bar, b.x, nloc, nx); b.st[0] = nloc; b.st[1] = nx; }
        const unsigned old = xb_add(&bar[XB_XSUB(b.x)], 1u);
        const unsigned gen = old / nloc;
        if (old + 1u == (gen + 1u) * nloc) {
            __builtin_amdgcn_fence(__ATOMIC_RELEASE, "agent");
            asm volatile("s_waitcnt vmcnt(0)" ::: "memory");
            const unsigned og = xb_add(&bar[XB_TOP], 1u);
            const unsigned tg = og / nx;
            if (og + 1u == (tg + 1u) * nx) xb_add(&bar[XB_TOPGEN], 1u);
            else XB_SPIN(xb_ld(&bar[XB_TOPGEN]) == tg, bar);
            __builtin_amdgcn_fence(__ATOMIC_ACQUIRE, "agent");
            xb_add(&bar[XB_XGEN(b.x)], 1u);
            asm volatile("s_waitcnt vmcnt(0)" ::: "memory");
        } else {
            XB_SPIN(xb_ld(&bar[XB_XGEN(b.x)]) == gen, bar);
            __builtin_amdgcn_fence(__ATOMIC_ACQUIRE, "agent");
            asm volatile("s_waitcnt vmcnt(0)" ::: "memory");
        }
    }
    __syncthreads();
}
__device__ __forceinline__ void seam_barrier(unsigned char* wsp, LAS unsigned char* lds) {
    XcdBarrier b; b.bar = (unsigned*)(wsp + O_BAR); b.x = xb_xcc_id(); b.st = (volatile LAS unsigned*)(lds + LDS_BYTES - 16);
    xcd_barrier(b);
}

__global__ void __launch_bounds__(512, 2) mega(Args args) {
    extern __shared__ __attribute__((aligned(16))) unsigned char smem[];
    LAS unsigned char* lds = (LAS unsigned char*)smem;
    cg::grid_group grid = cg::this_grid();
    if (threadIdx.x < 4) ((LAS unsigned*)(lds + LDS_BYTES - 16))[threadIdx.x] = 0u;
    __syncthreads();
    (void)xcd_barrier_post((unsigned*)(arg_ws() + O_BAR), (volatile LAS unsigned*)(lds + LDS_BYTES - 16));
    Ctx C; C.tid = threadIdx.x; C.lane = C.tid & 63; C.wave = __builtin_amdgcn_readfirstlane(C.tid >> 6); C.G = gridDim.x; C.gw = blockIdx.x * 8 + C.wave; C.NGW = C.G * 8;
#ifndef ENMASK
#define ENMASK 0xFFFFFFFFu
#endif
#define ws (arg_ws())
#define out (arg_out())
#define IN(k) (((ENMASK >> ((k) > 21 ? (k) - 13 : (k))) & 1u) && arg_int(232) <= (k) && (k) < arg_int(236))
#define SEAM(k) do { if (IN(k) && IN((k) + 1)) { if (arg_int(236) > 4096) grid.sync(); seam_barrier(ws, lds); } } while (0)
#ifndef REPMASK
#define REPMASK 0u
#endif
#define REPS(k) (((REPMASK >> (k)) & 1u) ? 2 : 1)
#define BT1 ((bf16_t*)(ws + O_BT1))
#define BT2 ((bf16_t*)(ws + O_BT2))
#define WOR ((bf16_t*)(ws + O_WOR))
#define WUP0 ((bf16_t*)(ws + O_WUP0))
#define WDN0 ((bf16_t*)(ws + O_WDN0))
#define Hb ((bf16_t*)(ws + O_H))
#define XM ((bf16_t*)(ws + O_XM))
#define DEC ((float*)(ws + O_DEC))
#define AA ((bf16_t*)(ws + O_AA))
#define RKV ((bf16_t*)(ws + O_RKV))
#define Gt ((bf16_t*)(ws + O_G))
#define BONUS ((float*)(ws + O_BONUS))
#define YG ((bf16_t*)(ws + O_YG))
#define STATS ((float*)ws)
#define RESB ((bf16_t*)(ws + O_RES))

    if (IN(0)) for (int rep = 0; rep < REPS(0); ++rep) {
        if (rep) grid.sync();
        for (int c = 0; c < 3; ++c) transpose_mat(C, lds, arg_in(2) + (size_t)c * D * D, D, D, BT1 + (size_t)c * D * D);
        transpose_mat(C, lds, arg_in(4), D, 96, BT1 + (size_t)6144 * D);
        zero_fill16(C, BT1 + (size_t)(6144 + 96) * D, (size_t)160 * D * 2 / 16);
        transpose_mat(C, lds, arg_in(7), D, 96, BT1 + (size_t)6400 * D);
        zero_fill16(C, BT1 + (size_t)(6400 + 96) * D, (size_t)160 * D * 2 / 16);
        transpose_mat(C, lds, arg_in(9), D, 256, BT1 + (size_t)6656 * D);
        transpose_pad96(C, arg_in(5), BT2);
        transpose_pad96(C, arg_in(8), BT2 + (size_t)2048 * 256);
        transpose_mat(C, lds, arg_in(10), 256, D, BT2 + (size_t)4096 * 256);
        mix_phase(C, arg_in(0), arg_in(1), 0, 2, 3, XM);
    }
    SEAM(0);
    if (IN(1)) {
        pg8::Gemm g{XM, BT1, D, D, D}; pg8::Order S; S.init(64, 8, 3, 64, C.G, (int)blockIdx.x);
        pg8::Epi<0> E{{RKV, nullptr, nullptr, nullptr, nullptr, (size_t)M * D, D, 8}};
        pg8::gemm_phase(lds, g, S, E);
    }
    SEAM(1);
    if (IN(2)) mix_phase(C, arg_in(0), arg_in(1), 1, 4, 5, XM);
    SEAM(2);
    if (IN(3)) {
        pg8::Gemm g{XM, BT1 + (size_t)6144 * D, D, D, D}; pg8::Order S; S.init(64, 1, 3, 64, C.G, (int)blockIdx.x);
        pg8::Epi<1> E{{Hb, nullptr, nullptr, nullptr, nullptr, (size_t)M * 256, 256, 1}};
        pg8::gemm_phase(lds, g, S, E);
    }
    SEAM(3);
    if (IN(4)) {
        pg8::Gemm g{Hb, BT2, 256, 256, 256}; pg8::Order S; S.init(64, 8, 3, 64, C.G, (int)blockIdx.x);
        pg8::Epi<2> E{{DEC, AA, Gt, arg_in(3), arg_in(6), 0, D, 8}};
        pg8::gemm_phase(lds, g, S, E);
    }
    SEAM(4);
    if (IN(5)) {
        ScanP P{RKV, RKV + (size_t)M * D, RKV + (size_t)2 * M * D, AA, (const bf16_t*)DEC, arg_in(11), arg_in(12), arg_in(13), (bf16_t*)out, BONUS,
                arg_in(19) + (size_t)D * FF2, arg_in(22) + (size_t)FF * D, arg_in(18), (bf16_t*)(ws + O_WUP1), (bf16_t*)(ws + O_WDN1), (bf16_t*)(ws + O_WOA),
                arg_in(19), arg_in(22), arg_in(16), WUP0, WDN0, WOR};
        for (int rep = 0; rep < REPS(5); ++rep) { if (rep) grid.sync(); scan_phase(P, lds, C.G); }
    }
    SEAM(5);
    if (IN(6)) post_phase(C, (const bf16_t*)out, RKV + (size_t)2 * M * D, Gt, BONUS, arg_in(14), arg_in(15), YG);
    SEAM(6);
    if (IN(7)) {
        pg8::Gemm g{YG, WOR, D, D, D}; pg8::Order S; S.init(64, 8, 1, 0, C.G, (int)blockIdx.x);
        pg8::Epi<3> E{{RESB, nullptr, nullptr, arg_in(0), nullptr, 0, D, 8}};
        pg8::gemm_phase(lds, g, S, E);
    }
    SEAM(7);
    if (IN(8)) ln_phase(C, RESB, arg_in(23), arg_in(24), nullptr, (bf16_t*)(ws + O_X1B), STATS);
    SEAM(8);
#pragma unroll 1
    for (int L = 0; L < 2; ++L) {
        const int pb = L == 0 ? 9 : 22;
        bf16_t* HF = (bf16_t*)(ws + (L == 0 ? O_HF0 : O_HF1));
        const bf16_t* XB = (const bf16_t*)(ws + (L == 0 ? O_X1B : O_X3B));
        const bf16_t* WUP = (const bf16_t*)(ws + (L == 0 ? O_WUP0 : O_WUP1));
        const bf16_t* WDN = (const bf16_t*)(ws + (L == 0 ? O_WDN0 : O_WDN1));
        if (L == 1) {
            bf16_t* X2B = (bf16_t*)(ws + O_X2B); bf16_t* WIN = (bf16_t*)(ws + O_WIN); bf16_t* WOA = (bf16_t*)(ws + O_WOA);
            bf16_t* QKV = (bf16_t*)(ws + O_QKV); bf16_t* OG = (bf16_t*)(ws + O_OG); float* LSE = (float*)(ws + O_LSE); bf16_t* OM = (bf16_t*)(ws + O_OM);
#pragma unroll 1
            for (int gi = 0; gi < 3; ++gi) {
                if (IN(13 + 2 * gi)) {
                    pg8::Gemm g{X2B, WIN + (size_t)gi * NQKV * D, D, D, D}; pg8::Order S; S.init(64, 24, 1, 0, C.G, (int)blockIdx.x);
                    pg8::Epi<0> E{{QKV, nullptr, nullptr, nullptr, nullptr, 0, NQKV, 24}};
                    pg8::gemm_phase(lds, g, S, E);
                }
                SEAM(13 + 2 * gi);
                if (IN(14 + 2 * gi)) attn_phase(QKV, OG, LSE, gi == 0 ? 1 : (gi == 1 ? 4 : 16), lds, C.G, gi > 0 ? 1 : 0);
                if (gi < 2) SEAM(14 + 2 * gi); else { if (IN(18) && IN(20)) seam_barrier(ws, lds); }
            }
            if (IN(20)) {
                pg8::Gemm g{OG, WOA, D, D, D}; pg8::Order S; S.init(64, 8, 1, 0, C.G, (int)blockIdx.x);
                pg8::Epi<4> E{{RESB, STATS, nullptr, arg_in(25), arg_in(26), 0, D, 8}};
                pg8::gemm_phase(lds, g, S, E);
            }
            SEAM(20);
            if (IN(21)) {
                ln_phase(C, RESB, arg_in(23) + D, arg_in(24) + D, nullptr, (bf16_t*)(ws + O_X3B), STATS);
            }
            SEAM(21);
        }
        if (IN(pb)) {
            pg8::Gemm g{XB, WUP, D, D, D}; pg8::Order S; S.init(64, 44, 1, 0, C.G, (int)blockIdx.x);
            pg8::Epi<5> E{{HF, (float*)(HF + (size_t)M * FF), (float*)(HF + (size_t)M * FF) + (size_t)256 * 4 * FF, arg_in(20) + (size_t)L * 3 * FF, arg_in(21) + (size_t)L * FF, 0, FF, 44}};
            pg8::gemm_phase(lds, g, S, E);
        }
        SEAM(pb);
        if (IN(pb + 1)) convfix_phase(C, HF, (const float*)(HF + (size_t)M * FF), (const float*)(HF + (size_t)M * FF) + (size_t)256 * 4 * FF, arg_in(20) + (size_t)L * 3 * FF, arg_in(21) + (size_t)L * FF);
        SEAM(pb + 1);
        if (IN(pb + 2)) {
            pg8::Gemm g{HF, WDN, FF, FF, FF}; pg8::Order S; S.init(64, 8, 1, 0, C.G, (int)blockIdx.x);
            pg8::Epi<4> E{{RESB, STATS, nullptr, arg_in(23) + (size_t)L * D, arg_in(24) + (size_t)L * D, 0, D, 8}};
            pg8::gemm_phase(lds, g, S, E);
        }
        SEAM(pb + 2);
        if (IN(pb + 3)) {
            if (L == 0) {
                ln_phase(C, RESB, arg_in(25), arg_in(26), nullptr, (bf16_t*)(ws + O_X2B), STATS);
                transpose_mat(C, lds, arg_in(17), D, 3 * NQKV, (bf16_t*)(ws + O_WIN));
            } else {
                ln_phase(C, RESB, arg_in(25) + D, arg_in(26) + D, out, nullptr, nullptr);
            }
        }
        if (L == 0) SEAM(12);
    }
#undef IN
#undef SEAM
#undef ws
#undef out
}

extern "C" void kernel_launch(void* const* d_in, const int* in_sizes, int n_in, void* d_out, int out_size, void* d_ws, size_t ws_size, hipStream_t stream) {
    static int grid = 0;
    if (grid == 0) {
        if (n_in != 27 || out_size != M * D || ws_size < WS_NEED) { fprintf(stderr, "kernel_launch: unexpected shapes (n_in %d, out %d, ws %zu)\n", n_in, out_size, ws_size); grid = -1; return; }
        int dev = 0, cus = 0, per_cu = 0;
        hipGetDevice(&dev);
        hipDeviceGetAttribute(&cus, hipDeviceAttributeMultiprocessorCount, dev);
        if (hipFuncSetAttribute((const void*)mega, hipFuncAttributeMaxDynamicSharedMemorySize, LDS_BYTES) != hipSuccess) { fprintf(stderr, "kernel_launch: hipFuncSetAttribute failed\n"); grid = -1; return; }
        if (hipOccupancyMaxActiveBlocksPerMultiprocessor(&per_cu, (const void*)mega, 512, LDS_BYTES) != hipSuccess || per_cu < 1) per_cu = 1;
        (void)hipGetLastError();
        grid = cus * 1;
    }
    if (grid < 0) return;
    if (hipMemsetAsync((char*)d_ws + O_BAR, 0, XCD_BAR_WORDS * 4, stream) != hipSuccess) { fprintf(stderr, "kernel_launch: memset of barrier words failed\n"); return; }
    Args a{};
    for (int i = 0; i < 27; ++i) a.in[i] = (const float*)d_in[i];
    a.out = (float*)d_out; a.ws = (unsigned char*)d_ws; a.ph_lo = 0; a.ph_hi = 26;
    void* kargs[] = {&a};
    hipError_t e = hipLaunchCooperativeKernel((const void*)mega, dim3(grid), dim3(512), kargs, LDS_BYTES, stream);
    if (e != hipSuccess) fprintf(stderr, "kernel_launch: cooperative launch failed: %s (grid %d)\n", hipGetErrorString(e), grid);
}
```

```cpp
#include <hip/hip_runtime.h>
#include <hip/hip_cooperative_groups.h>
#include <cstdio>
#include <cstdint>
namespace cg = cooperative_groups;

#define LAS __attribute__((address_space(3)))
typedef unsigned short bf16_t;
typedef short bf16x8 __attribute__((ext_vector_type(8)));
typedef float f32x4 __attribute__((ext_vector_type(4)));
typedef float f32x2 __attribute__((ext_vector_type(2)));
typedef unsigned u32x4 __attribute__((ext_vector_type(4)));
typedef unsigned u32x2 __attribute__((ext_vector_type(2)));

constexpr int D = 2048, SEQ = 4096, NB = 4, M = NB * SEQ;
constexpr int FF = 5632, FF2 = 2 * FF;
constexpr int NQKV = 6144;
constexpr float LN_EPS = 1e-5f, GN_EPS = 64e-5f;
constexpr float ALPHA = 1.41421356237309515f;

constexpr size_t MiB = 1u << 20;
constexpr size_t O_BT1 = 1 * MiB, O_BT2 = 28 * MiB, O_WOR = 31 * MiB, O_WUP0 = 39 * MiB, O_WDN0 = 83 * MiB, O_H = 105 * MiB;
constexpr size_t O_XM = 129 * MiB, O_DEC = 129 * MiB, O_AA = 257 * MiB, O_RKV = 321 * MiB, O_G = 513 * MiB, O_BONUS = 577 * MiB, O_YG = 579 * MiB;
constexpr size_t O_RES = 513 * MiB;
constexpr size_t O_PRE = 129 * MiB, O_X1B = 129 * MiB, O_HF0 = 193 * MiB, O_PRE2 = 129 * MiB, O_X2B = 1 * MiB, O_WIN = 321 * MiB, O_WOA = 687 * MiB;
constexpr size_t O_QKV = 129 * MiB, O_OG = 401 * MiB, O_LSE = 593 * MiB, O_OM = 1 * MiB, O_PRE3 = 65 * MiB, O_X3B = 1 * MiB, O_WUP1 = 643 * MiB, O_WDN1 = 105 * MiB;
constexpr size_t O_HF1 = 259 * MiB, O_PRE4 = 65 * MiB;
constexpr size_t WS_NEED = 696 * MiB;
constexpr int LDS_BYTES = 147456;

typedef __bf16 bf16x2_t __attribute__((ext_vector_type(2)));
__device__ __forceinline__ unsigned cvt_pk_bf16(float lo, float hi) { const f32x2 v = {lo, hi}; return __builtin_bit_cast(unsigned, __builtin_convertvector(v, bf16x2_t)); }
__device__ __forceinline__ float bflo(unsigned w) { return __builtin_bit_cast(float, w << 16); }
__device__ __forceinline__ float bfhi(unsigned w) { return __builtin_bit_cast(float, w & 0xffff0000u); }
template <int CTRL> __device__ __forceinline__ float dppf(float v) { return __builtin_bit_cast(float, __builtin_amdgcn_update_dpp(0, __builtin_bit_cast(int, v), CTRL, 0xf, 0xf, false)); }
__device__ __forceinline__ float red16(float v) { v += dppf<0xB1>(v); v += dppf<0x4E>(v); v += dppf<0x141>(v); v += dppf<0x128>(v); return v; }
__device__ __forceinline__ float red8(float v) { v += dppf<0xB1>(v); v += dppf<0x4E>(v); v += dppf<0x141>(v); return v; }
__device__ __forceinline__ float wave_sum(float v) {
    v += dppf<0xB1>(v); v += dppf<0x4E>(v); v += dppf<0x141>(v); v += dppf<0x128>(v);
    v += __shfl_xor(v, 16); v += __shfl_xor(v, 32);
    return v;
}
__device__ __forceinline__ float sigmoidf_(float x) { return __builtin_amdgcn_rcpf(1.0f + __expf(-x)); }
__device__ __forceinline__ float tanh_fast(float x) { return 1.0f - 2.0f * __builtin_amdgcn_rcpf(1.0f + __expf(2.0f * x)); }

namespace pg8 {
constexpr int BM = 256, BK = 64, HALF = 128, HTB = HALF * BK * 2, STAGE_BYTES = 8 * HTB, NXCD = 8, WGM = 8;
__host__ __device__ __forceinline__ int lds_byte(int r, int c) { const int st = (r >> 4) * 2 + (c >> 5), rr = r & 15, cc = c & 31, ob = rr * 64 + cc * 2; return st * 1024 + (ob ^ (((ob >> 9) & 1) << 5)); }
__host__ __device__ __forceinline__ void stage_rc(int b, int& R, int& C) { const int st = b / 1024, sb = b % 1024, swz = sb ^ (((sb >> 9) & 1) << 5); R = (st >> 1) * 16 + swz / 64; C = (st & 1) * 32 + (swz % 64) / 2; }
__host__ __device__ __forceinline__ int perm32(int rho) { const int n = rho >> 4, i = rho & 15; return 8 * (i >> 2) + 4 * n + (i & 3); }

struct Unit { int pm, pn; };
struct Gemm { const bf16_t* A; const bf16_t* Bt; int K, lda, ldb; };

struct Order {
    int nM, nN, per, nsub, aoff, G, c;
    __device__ void init(int nM_, int nN_, int nsub_, int aoff_, int G_, int c_) { nM = nM_; nN = nN_; per = nM_ * nN_; nsub = nsub_; aoff = aoff_; G = G_; c = c_; }
    __device__ bool next(int i, Unit& u) const {
        const long L = (long)i * G + c; if (L >= (long)per * nsub) return false;
        const int sub = (int)(L / per); int wgid = (int)(L % per);
        { const int q = per / NXCD, r = per % NXCD, xcd = wgid % NXCD, off = wgid / NXCD; wgid = (xcd < r ? xcd * (q + 1) : r * (q + 1) + (xcd - r) * q) + off; }
        const int nig = WGM * nN, gid = wgid / nig, fm = gid * WGM, gsz = (nM - fm) < WGM ? (nM - fm) : WGM;
        u.pm = sub * aoff + fm + ((wgid % nig) % gsz); u.pn = sub * nN + (wgid % nig) / gsz; return true;
    }
};

template <class Epi>
__device__ __forceinline__ void gemm_phase(LAS unsigned char* lds, const Gemm g, const Order& S, const Epi& E) {
    int tid_ = threadIdx.x; asm volatile("" : "+v"(tid_));
    const int tid = tid_, wid = __builtin_amdgcn_readfirstlane(tid >> 6), lane = tid & 63, wr = wid >> 2, wc = wid & 3, fr = lane & 15, fq = lane >> 4;
    const int K = g.K, nt = K / BK;
    unsigned voffA[2], voffB[2];
#pragma unroll
    for (int i = 0; i < 2; ++i) { int R, C; stage_rc(tid * 16 + i * 8192, R, C); const int Rb = (R & ~31) + perm32(R & 31);
        voffA[i] = (unsigned)(R * g.lda + C) * 2u; voffB[i] = (unsigned)(Rb * g.ldb + C) * 2u; }
    const size_t kstep = (size_t)(BK * 2);
    const size_t hA = (size_t)HALF * g.lda * 2, hB = (size_t)HALF * g.ldb * 2;
    const size_t tA = 2 * hA, tB = 2 * hB;
    const unsigned ldsw = (unsigned)wid * 1024u;
    const int aoff = lds_byte(wr * 64 + fr, fq * 8), boff = lds_byte(wc * 32 + fr, fq * 8);
#define PG8_SA(b, h) (((b) * 2 + (h)) * HTB)
#define PG8_SB(b, h) ((4 + (b) * 2 + (h)) * HTB)
#define PG8_STAGE(bufoff, gbase, voff) do { _Pragma("unroll") for (int _i = 0; _i < 2; ++_i) \
        __builtin_amdgcn_global_load_lds((const unsigned*)((const char*)(gbase) + (voff)[_i]), (LAS unsigned*)(lds + (bufoff) + ldsw + _i * 8192), 16, 0, 0); } while (0)
#define PG8_LDA(dst, b, h) do { _Pragma("unroll") for (int m = 0; m < 4; ++m) _Pragma("unroll") for (int k = 0; k < 2; ++k) dst[m][k] = *(const LAS bf16x8*)(lds + PG8_SA(b, h) + aoff + m * 2048 + k * 1024); } while (0)
#define PG8_LDB(dst, b, h) do { _Pragma("unroll") for (int n = 0; n < 2; ++n) _Pragma("unroll") for (int k = 0; k < 2; ++k) dst[n][k] = *(const LAS bf16x8*)(lds + PG8_SB(b, h) + boff + n * 2048 + k * 1024); } while (0)
#define PG8_MMA(ai, bj, At, Bt) do { __builtin_amdgcn_s_setprio(1); _Pragma("unroll") for (int m = 0; m < 4; ++m) _Pragma("unroll") for (int n = 0; n < 2; ++n) _Pragma("unroll") for (int k = 0; k < 2; ++k) \
        acc[ai][bj][m][n] = __builtin_amdgcn_mfma_f32_16x16x32_bf16(Bt[n][k], At[m][k], acc[ai][bj][m][n], 0, 0, 0); __builtin_amdgcn_s_setprio(0); } while (0)
#define PG8_WAIT_V(n) asm volatile("s_waitcnt vmcnt(" #n ")" ::: "memory")
#define PG8_WAIT_L(n) asm volatile("s_waitcnt lgkmcnt(" #n ")" ::: "memory")
#define PG8_BAR __builtin_amdgcn_s_barrier()
#define PG8_SCHED __builtin_amdgcn_sched_barrier(0)
    Unit cur, nxt; int ui = 0;
    if (!S.next(0, cur)) return;
    f32x4 acc[2][2][4][2];
#pragma unroll
    for (int a = 0; a < 2; ++a)
#pragma unroll
        for (int b = 0; b < 2; ++b)
#pragma unroll
            for (int m = 0; m < 4; ++m)
#pragma unroll
                for (int n = 0; n < 2; ++n) acc[a][b][m][n] = (f32x4){0.f, 0.f, 0.f, 0.f};
    bf16x8 At[4][2], B0[2][2], B1[2][2];
    const char* cA = (const char*)g.A + (size_t)cur.pm * tA; const char* cB = (const char*)g.Bt + (size_t)cur.pn * tB;
    PG8_STAGE(PG8_SB(0, 0), cB, voffB); PG8_STAGE(PG8_SA(0, 0), cA, voffA); PG8_STAGE(PG8_SB(0, 1), cB + hB, voffB); PG8_STAGE(PG8_SA(0, 1), cA + hA, voffA);
    if (wr == 1) PG8_BAR;
    PG8_WAIT_V(4); PG8_BAR;
    PG8_STAGE(PG8_SB(1, 0), cB + kstep, voffB); PG8_STAGE(PG8_SA(1, 0), cA + kstep, voffA); PG8_STAGE(PG8_SB(1, 1), cB + hB + kstep, voffB);
    PG8_WAIT_V(6); PG8_BAR;
    for (;;) {
        const bool has_next = S.next(ui + 1, nxt);
        const char* nA = has_next ? (const char*)g.A + (size_t)nxt.pm * tA : cA; const char* nB = has_next ? (const char*)g.Bt + (size_t)nxt.pn * tB : cB;
        for (int t = 0; t < nt; t += 2) {
            const bool last = (t == nt - 2);
            const char* a1 = cA + (size_t)(t + 1) * kstep;
            const char* a2 = last ? nA : cA + (size_t)(t + 2) * kstep; const char* b2 = last ? nB : cB + (size_t)(t + 2) * kstep;
            const char* a3 = a2 + kstep; const char* b3 = b2 + kstep;
            PG8_LDB(B0, 0, 0); PG8_SCHED; PG8_LDA(At, 0, 0); PG8_STAGE(PG8_SA(1, 1), a1 + hA, voffA);
            PG8_WAIT_L(8); PG8_BAR; PG8_WAIT_L(0); PG8_MMA(0, 0, At, B0); PG8_BAR; PG8_SCHED;
            PG8_LDB(B1, 0, 1); PG8_STAGE(PG8_SB(0, 0), b2, voffB);
            PG8_BAR; PG8_WAIT_L(0); PG8_MMA(0, 1, At, B1); PG8_BAR;
            PG8_LDA(At, 0, 1); PG8_STAGE(PG8_SA(0, 0), a2, voffA);
            PG8_BAR; PG8_WAIT_L(0); PG8_MMA(1, 0, At, B0); PG8_BAR; PG8_SCHED;
            PG8_STAGE(PG8_SB(0, 1), b2 + hB, voffB);
            PG8_WAIT_V(6); PG8_BAR; PG8_MMA(1, 1, At, B1); PG8_BAR;
            PG8_LDB(B0, 1, 0); PG8_SCHED; PG8_LDA(At, 1, 0); PG8_STAGE(PG8_SA(0, 1), a2 + hA, voffA);
            PG8_WAIT_L(8); PG8_BAR; PG8_WAIT_L(0); PG8_MMA(0, 0, At, B0); PG8_BAR; PG8_SCHED;
            PG8_LDB(B1, 1, 1); PG8_STAGE(PG8_SB(1, 0), b3, voffB);
            PG8_BAR; PG8_WAIT_L(0); PG8_MMA(0, 1, At, B1); PG8_BAR;
            PG8_LDA(At, 1, 1); PG8_STAGE(PG8_SA(1, 0), a3, voffA);
            PG8_BAR; PG8_WAIT_L(0); PG8_MMA(1, 0, At, B0); PG8_BAR; PG8_SCHED;
            PG8_STAGE(PG8_SB(1, 1), b3 + hB, voffB);
            PG8_WAIT_V(6); PG8_BAR; PG8_MMA(1, 1, At, B1); PG8_BAR;
        }
        E(acc, cur, wr, wc, fr, fq);
        if (!has_next) break;
#pragma unroll
        for (int a = 0; a < 2; ++a)
#pragma unroll
            for (int b = 0; b < 2; ++b)
#pragma unroll
                for (int m = 0; m < 4; ++m)
#pragma unroll
                    for (int n = 0; n < 2; ++n) acc[a][b][m][n] = (f32x4){0.f, 0.f, 0.f, 0.f};
        cur = nxt; cA = nA; cB = nB; ++ui;
    }
    PG8_WAIT_V(0);
    if (wr == 0) PG8_BAR;
    PG8_BAR;
#undef PG8_SA
#undef PG8_SB
#undef PG8_STAGE
#undef PG8_LDA
#undef PG8_LDB
#undef PG8_MMA
#undef PG8_WAIT_V
#undef PG8_WAIT_L
#undef PG8_BAR
#undef PG8_SCHED
}

struct EpiArgs { void* o0; void* o1; void* o2; const float* p0; const float* p1; size_t sstride; int ldc; int nN; };
template <int MODE> struct Epi {
    EpiArgs a;
    __device__ __forceinline__ void operator()(const f32x4 (&acc)[2][2][4][2], const Unit& u, int wr, int wc, int fr, int fq) const {
        const int sub = u.pn / a.nN;
        const int row0 = (u.pm & 63) * BM + wr * 64 + fr, col0 = (u.pn - sub * a.nN) * BM + wc * 32 + 8 * fq;
        if constexpr (MODE == 0 || MODE == 1) {
            bf16_t* base = (bf16_t*)a.o0 + (size_t)sub * a.sstride;
#pragma unroll
            for (int ai = 0; ai < 2; ++ai)
#pragma unroll
                for (int m = 0; m < 4; ++m) { bf16_t* rowp = base + (size_t)(row0 + ai * HALF + m * 16) * a.ldc + col0;
#pragma unroll
                    for (int bj = 0; bj < 2; ++bj) { f32x4 v0 = acc[ai][bj][m][0], v1 = acc[ai][bj][m][1];
                        if constexpr (MODE == 1) {
                            if (sub == 0) {
#pragma unroll
                                for (int j = 0; j < 4; ++j) { v0[j] = tanh_fast(v0[j]); v1[j] = tanh_fast(v1[j]); } }
                            else if (sub == 2) {
#pragma unroll
                                for (int j = 0; j < 4; ++j) { v0[j] = sigmoidf_(v0[j]); v1[j] = sigmoidf_(v1[j]); } }
                        }
                        u32x4 w; w.x = cvt_pk_bf16(v0[0], v0[1]); w.y = cvt_pk_bf16(v0[2], v0[3]); w.z = cvt_pk_bf16(v1[0], v1[1]); w.w = cvt_pk_bf16(v1[2], v1[3]);
                        *(u32x4*)(rowp + bj * HALF) = w; } }
        } else if constexpr (MODE == 2) {
            if (sub == 0) {
#pragma unroll
                for (int bj = 0; bj < 2; ++bj) {
                    const int c = col0 + bj * HALF;
                    const f32x4 p0v = *(const f32x4*)(a.p0 + c), p1v = *(const f32x4*)(a.p0 + c + 4);
#pragma unroll
                    for (int ai = 0; ai < 2; ++ai)
#pragma unroll
                        for (int m = 0; m < 4; ++m) { bf16_t* dst = (bf16_t*)a.o0 + (size_t)(row0 + ai * HALF + m * 16) * D + c;
                            f32x4 v0 = acc[ai][bj][m][0] + p0v, v1 = acc[ai][bj][m][1] + p1v;
#pragma unroll
                            for (int j = 0; j < 4; ++j) {
                                v0[j] = -0.6065306597126334f * __builtin_amdgcn_rcpf(1.0f + __expf(-v0[j]));
                                v1[j] = -0.6065306597126334f * __builtin_amdgcn_rcpf(1.0f + __expf(-v1[j])); }
                            u32x4 w8; w8.x = cvt_pk_bf16(v0[0], v0[1]); w8.y = cvt_pk_bf16(v0[2], v0[3]); w8.z = cvt_pk_bf16(v1[0], v1[1]); w8.w = cvt_pk_bf16(v1[2], v1[3]);
                            *(u32x4*)dst = w8; asm volatile("" ::: "memory"); }
                }
            } else if (sub == 1) {
#pragma unroll
                for (int bj = 0; bj < 2; ++bj) {
                    const int c = col0 + bj * HALF;
                    const f32x4 p0v = *(const f32x4*)(a.p1 + c), p1v = *(const f32x4*)(a.p1 + c + 4);
#pragma unroll
                    for (int ai = 0; ai < 2; ++ai)
#pragma unroll
                        for (int m = 0; m < 4; ++m) { bf16_t* dst = (bf16_t*)a.o1 + (size_t)(row0 + ai * HALF + m * 16) * D + c;
                            f32x4 v0 = acc[ai][bj][m][0] + p0v, v1 = acc[ai][bj][m][1] + p1v;
#pragma unroll
                            for (int j = 0; j < 4; ++j) { v0[j] = sigmoidf_(v0[j]); v1[j] = sigmoidf_(v1[j]); }
                            u32x4 w; w.x = cvt_pk_bf16(v0[0], v0[1]); w.y = cvt_pk_bf16(v0[2], v0[3]); w.z = cvt_pk_bf16(v1[0], v1[1]); w.w = cvt_pk_bf16(v1[2], v1[3]);
                            *(u32x4*)dst = w; asm volatile("" ::: "memory"); }
                }
            } else {
#pragma unroll
                for (int ai = 0; ai < 2; ++ai)
#pragma unroll
                    for (int m = 0; m < 4; ++m) { bf16_t* rowp = (bf16_t*)a.o2 + (size_t)(row0 + ai * HALF + m * 16) * D + col0;
#pragma unroll
                        for (int bj = 0; bj < 2; ++bj) { const f32x4 v0 = acc[ai][bj][m][0], v1 = acc[ai][bj][m][1];
                            u32x4 w; w.x = cvt_pk_bf16(v0[0], v0[1]); w.y = cvt_pk_bf16(v0[2], v0[3]); w.z = cvt_pk_bf16(v1[0], v1[1]); w.w = cvt_pk_bf16(v1[2], v1[3]);
                            *(u32x4*)(rowp + bj * HALF) = w; } }
            }
        } else if constexpr (MODE == 5) {
            bf16_t* ACT = (bf16_t*)a.o0; float* GS = (float*)a.o1; float* US = (float*)a.o2;
            const int chan0 = u.pn * HALF + wc * 32 + 8 * fq;
#pragma unroll
            for (int n = 0; n < 2; ++n) {
                const int c = chan0 + 4 * n;
                const f32x4 w0 = *(const f32x4*)(a.p0 + c), w1 = *(const f32x4*)(a.p0 + FF + c), w2 = *(const f32x4*)(a.p0 + 2 * FF + c), cb = *(const f32x4*)(a.p1 + c);
#pragma unroll
                for (int ai = 0; ai < 2; ++ai)
#pragma unroll
                    for (int m = 0; m < 4; ++m) {
                        const f32x4 g0 = acc[ai][0][m][n], up = acc[ai][1][m][n];
                        f32x4 g1, g2;
#pragma unroll
                        for (int j = 0; j < 4; ++j) {
                            const int ln = (int)(threadIdx.x & 63);
                            const float cur = g0[j];
                            const float prev = (m > 0) ? acc[ai][0][m > 0 ? m - 1 : 0][n][j] : 0.f;
                            const float t1c = __builtin_bit_cast(float, __builtin_amdgcn_update_dpp(0, __builtin_bit_cast(int, cur), 0x111, 0xf, 0xf, true)), t1p = __shfl(prev, (ln + 15) & 63);
                            const float t2c = __builtin_bit_cast(float, __builtin_amdgcn_update_dpp(0, __builtin_bit_cast(int, cur), 0x112, 0xf, 0xf, true)), t2p = __shfl(prev, (ln + 14) & 63);
                            g1[j] = (fr >= 1) ? t1c : t1p;
                            g2[j] = (fr >= 2) ? t2c : t2p;
                        }
                        const f32x4 av = cb + w0 * g2 + w1 * g1 + w2 * g0;
                        f32x4 o;
#pragma unroll
                        for (int j = 0; j < 4; ++j) o[j] = av[j] * __builtin_amdgcn_rcpf(1.0f + __expf(-av[j])) * up[j];
                        const int row = row0 + ai * HALF + m * 16;
                        if (!(m == 0 && fr < 2)) { u32x2 w; w.x = cvt_pk_bf16(o[0], o[1]); w.y = cvt_pk_bf16(o[2], o[3]); *(u32x2*)(ACT + (size_t)row * FF + c) = w; }
                        if (m == 0 && fr < 2) { const int grp = row >> 6; *(f32x4*)(GS + ((size_t)grp * 4 + fr) * FF + c) = g0; *(f32x4*)(US + ((size_t)grp * 2 + fr) * FF + c) = up; }
                        if (m == 3 && fr >= 14) { const int grp = row >> 6; *(f32x4*)(GS + ((size_t)grp * 4 + 2 + (fr - 14)) * FF + c) = g0; }
                    }
            }
        } else if constexpr (MODE == 4) {
            bf16_t* RES = (bf16_t*)a.o0; const float* st = (const float*)a.o1;
#pragma unroll
            for (int bj = 0; bj < 2; ++bj) {
                const int c = col0 + bj * HALF;
                const f32x4 g0 = *(const f32x4*)(a.p0 + c), g1 = *(const f32x4*)(a.p0 + c + 4), b0 = *(const f32x4*)(a.p1 + c), b1 = *(const f32x4*)(a.p1 + c + 4);
#pragma unroll
                for (int ai = 0; ai < 2; ++ai)
#pragma unroll
                    for (int m = 0; m < 4; ++m) { const int row = row0 + ai * HALF + m * 16; const f32x2 ms = *(const f32x2*)(st + 2 * (size_t)row);
                        bf16_t* p = RES + (size_t)row * D + c;
                        const u32x4 rw8 = *(const u32x4*)p;
                        const f32x4 r0 = (f32x4){bflo(rw8.x), bfhi(rw8.x), bflo(rw8.y), bfhi(rw8.y)}, r1 = (f32x4){bflo(rw8.z), bfhi(rw8.z), bflo(rw8.w), bfhi(rw8.w)};
                        const f32x4 o0 = ((r0 - ms.x) * ms.y * g0 + b0) * ALPHA + acc[ai][bj][m][0], o1 = ((r1 - ms.x) * ms.y * g1 + b1) * ALPHA + acc[ai][bj][m][1];
                        u32x4 w8; w8.x = cvt_pk_bf16(o0[0], o0[1]); w8.y = cvt_pk_bf16(o0[2], o0[3]); w8.z = cvt_pk_bf16(o1[0], o1[1]); w8.w = cvt_pk_bf16(o1[2], o1[3]);
                        *(u32x4*)p = w8; }
                asm volatile("" ::: "memory");
            }
        } else {
#pragma unroll
            for (int ai = 0; ai < 2; ++ai)
#pragma unroll
                for (int m = 0; m < 4; ++m) { const size_t off = (size_t)(row0 + ai * HALF + m * 16) * a.ldc + col0;
#pragma unroll
                    for (int bj = 0; bj < 2; ++bj) {
                        const f32x4 r0 = *(const f32x4*)(a.p0 + off + bj * HALF), r1 = *(const f32x4*)(a.p0 + off + bj * HALF + 4);
                        const f32x4 o0 = r0 * ALPHA + acc[ai][bj][m][0], o1 = r1 * ALPHA + acc[ai][bj][m][1];
                        u32x4 w8; w8.x = cvt_pk_bf16(o0[0], o0[1]); w8.y = cvt_pk_bf16(o0[2], o0[3]); w8.z = cvt_pk_bf16(o1[0], o1[1]); w8.w = cvt_pk_bf16(o1[2], o1[3]);
                        *(u32x4*)((bf16_t*)a.o0 + off + bj * HALF) = w8; }
                    asm volatile("" ::: "memory"); }
        }
    }
};
}

struct Args {
    const float* in[27];
    float* out;
    unsigned char* ws;
    int ph_lo, ph_hi;
};

struct Ctx { int tid, lane, wave, G, gw, NGW; };
__device__ __forceinline__ const float* arg_in(int k) {
    typedef const char __attribute__((address_space(4)))* kptr_t;
    kptr_t kp = (kptr_t)__builtin_amdgcn_kernarg_segment_ptr();
    asm volatile("" : "+s"(kp));
    return *(const float* const __attribute__((address_space(4)))*)(kp + 8 * k);
}
__device__ __forceinline__ float* arg_out() { return (float*)arg_in(27); }
__device__ __forceinline__ unsigned char* arg_ws() { return (unsigned char*)arg_in(28); }
__device__ __forceinline__ int arg_int(int byteoff) {
    typedef const char __attribute__((address_space(4)))* kptr_t;
    kptr_t kp = (kptr_t)__builtin_amdgcn_kernarg_segment_ptr();
    asm volatile("" : "+s"(kp));
    return *(const int __attribute__((address_space(4)))*)(kp + byteoff);
}
__device__ __forceinline__ int opaque_tid() { int t = threadIdx.x; asm volatile("" : "+v"(t)); return t; }
__device__ __forceinline__ Ctx mkctx() { Ctx C; C.tid = opaque_tid(); C.lane = C.tid & 63; C.wave = __builtin_amdgcn_readfirstlane(C.tid >> 6); C.G = gridDim.x;
    int b = blockIdx.x; asm volatile("" : "+s"(b)); C.gw = b * 8 + C.wave; C.NGW = C.G * 8; return C; }

__device__ __forceinline__ void transpose_item(const float* W, int K, int N, bf16_t* WT, LAS float* scr, int item, int lane) {
    const int nblk = N / 32, kb = item / nblk, nb = item % nblk, k0 = 64 * kb, n0 = 32 * nb;
#pragma unroll 8
    for (int i = 0; i < 32; ++i) { const int kk = 2 * i + (lane >> 5); scr[kk * 33 + (lane & 31)] = W[(size_t)(k0 + kk) * N + n0 + (lane & 31)]; }
    asm volatile("s_waitcnt lgkmcnt(0)" ::: "memory");
    const int c = lane & 7;
#pragma unroll
    for (int j = 0; j < 4; ++j) { const int n = (lane >> 3) + 8 * j; const LAS float* s = scr + (8 * c) * 33 + n;
        u32x4 o; o.x = cvt_pk_bf16(s[0 * 33], s[1 * 33]); o.y = cvt_pk_bf16(s[2 * 33], s[3 * 33]); o.z = cvt_pk_bf16(s[4 * 33], s[5 * 33]); o.w = cvt_pk_bf16(s[6 * 33], s[7 * 33]);
        *(u32x4*)(WT + (size_t)(n0 + n) * K + k0 + 8 * c) = o; }
    asm volatile("s_waitcnt lgkmcnt(0)" ::: "memory");
}
__device__ __forceinline__ void titem_issue(const float* W, int N, int item, int lane, float (&v)[32]) {
    const int nblk = N / 32, kb = item / nblk, nb = item % nblk, k0 = 64 * kb, n0 = 32 * nb;
#pragma unroll
    for (int i = 0; i < 32; ++i) { const int kk = 2 * i + (lane >> 5); v[i] = W[(size_t)(k0 + kk) * N + n0 + (lane & 31)]; }
}
__device__ __forceinline__ void titem_finish(int K, int N, bf16_t* WT, LAS float* scr, int item, int lane, int ffremap, const float (&v)[32]) {
    const int nblk = N / 32, kb = item / nblk, nb = item % nblk, k0 = 64 * kb, n0 = 32 * nb;
    int n0d = n0; if (ffremap) { const int hh = n0 / FF, cc = n0 - hh * FF; n0d = (cc >> 7) * 256 + hh * 128 + (cc & 127); }
#pragma unroll
    for (int i = 0; i < 32; ++i) { const int kk = 2 * i + (lane >> 5); scr[kk * 33 + (lane & 31)] = v[i]; }
    asm volatile("s_waitcnt lgkmcnt(0)" ::: "memory");
    const int c = lane & 7;
#pragma unroll
    for (int j = 0; j < 4; ++j) { const int n = (lane >> 3) + 8 * j; const LAS float* sp = scr + (8 * c) * 33 + n;
        u32x4 o; o.x = cvt_pk_bf16(sp[0 * 33], sp[1 * 33]); o.y = cvt_pk_bf16(sp[2 * 33], sp[3 * 33]); o.z = cvt_pk_bf16(sp[4 * 33], sp[5 * 33]); o.w = cvt_pk_bf16(sp[6 * 33], sp[7 * 33]);
        *(u32x4*)(WT + (size_t)(n0d + n) * K + k0 + 8 * c) = o; }
    asm volatile("s_waitcnt lgkmcnt(0)" ::: "memory");
}
__device__ __forceinline__ void transpose_item64(const float* W, int K, int N, bf16_t* WT, LAS float* scr, int item, int lane, int ffremap) {
    const int nblk = N / 64, kb = item / nblk, nb = item % nblk, k0 = 64 * kb, n0 = 64 * nb;
    int n0d = n0; if (ffremap) { const int hh = n0 / FF, cc = n0 - hh * FF; n0d = (cc >> 7) * 256 + hh * 128 + (cc & 127); }
    const int c4 = 4 * (lane & 15), kq = lane >> 4;
#pragma unroll 4
    for (int i = 0; i < 16; ++i) { const int kk = 4 * i + kq; const f32x4 v = *(const f32x4*)(W + (size_t)(k0 + kk) * N + n0 + c4);
        LAS float* d = scr + kk * 65 + c4; d[0] = v[0]; d[1] = v[1]; d[2] = v[2]; d[3] = v[3]; }
    asm volatile("s_waitcnt lgkmcnt(0)" ::: "memory");
    const int c = lane & 7;
#pragma unroll
    for (int j = 0; j < 8; ++j) { const int n = (lane >> 3) + 8 * j; const LAS float* sp = scr + (8 * c) * 65 + n;
        u32x4 o; o.x = cvt_pk_bf16(sp[0 * 65], sp[1 * 65]); o.y = cvt_pk_bf16(sp[2 * 65], sp[3 * 65]); o.z = cvt_pk_bf16(sp[4 * 65], sp[5 * 65]); o.w = cvt_pk_bf16(sp[6 * 65], sp[7 * 65]);
        *(u32x4*)(WT + (size_t)(n0d + n) * K + k0 + 8 * c) = o; }
    asm volatile("s_waitcnt lgkmcnt(0)" ::: "memory");
}
__device__ __forceinline__ void transpose_mat(const Ctx& C_unused, LAS unsigned char* lds, const float* W, int K, int N, bf16_t* WT, int ffremap = 0) {
    const Ctx C = mkctx();
    LAS float* scr = (LAS float*)(lds + C.wave * 16640);
    if (N % 64 == 0) {
        const int items = (K / 64) * (N / 64);
        for (int it = C.gw; it < items; it += C.NGW) transpose_item64(W, K, N, WT, scr, it, C.lane, ffremap);
    } else {
        const int items = (K / 64) * (N / 32);
        for (int it = C.gw; it < items; it += C.NGW) transpose_item(W, K, N, WT, scr, it, C.lane);
    }
}
__device__ __forceinline__ void transpose_pad96(const Ctx& C_unused, const float* W, bf16_t* WT) {
    const Ctx C = mkctx();
    const int gt = C.gw * 64 + C.lane, NT = C.NGW * 64;
    for (int idx = gt; idx < 2048 * 32; idx += NT) { const int n = idx & 2047, k8 = idx >> 11; u32x4 o = (u32x4){0u, 0u, 0u, 0u};
        if (k8 < 12) { float v[8];
#pragma unroll
            for (int j = 0; j < 8; ++j) v[j] = W[(size_t)(8 * k8 + j) * 2048 + n];
            o.x = cvt_pk_bf16(v[0], v[1]); o.y = cvt_pk_bf16(v[2], v[3]); o.z = cvt_pk_bf16(v[4], v[5]); o.w = cvt_pk_bf16(v[6], v[7]); }
        *(u32x4*)(WT + (size_t)n * 256 + 8 * k8) = o; }
}
__device__ __forceinline__ void zero_fill16(const Ctx& C_unused, void* p, size_t n16) {
    const Ctx C = mkctx();
    const size_t gt = (size_t)C.gw * 64 + C.lane, NT = (size_t)C.NGW * 64;
    for (size_t i = gt; i < n16; i += NT) ((u32x4*)p)[i] = (u32x4){0u, 0u, 0u, 0u};
}
__device__ __forceinline__ void mix_phase(const Ctx& C_unused, const float* x, const float* mu, int s0, int s1, int s2, bf16_t* XM) {
    const Ctx C = mkctx();
    const int gt = C.gw * 64 + C.lane, NT = C.NGW * 64;
    for (int idx = gt; idx < M * (D / 4); idx += NT) {
        const int t = idx >> 9, c4 = idx & 511;
        const f32x4 xv = ((const f32x4*)x)[idx];
        f32x4 xp = (f32x4){0.f, 0.f, 0.f, 0.f};
        if (t & (SEQ - 1)) xp = ((const f32x4*)x)[idx - 512];
        const f32x4 xx = xp - xv;
        const f32x4 m0 = ((const f32x4*)(mu + s0 * D))[c4], m1 = ((const f32x4*)(mu + s1 * D))[c4], m2 = ((const f32x4*)(mu + s2 * D))[c4];
        const f32x4 a = xv + xx * m0, b = xv + xx * m1, c = xv + xx * m2;
        u32x2 w;
        w.x = cvt_pk_bf16(a[0], a[1]); w.y = cvt_pk_bf16(a[2], a[3]); ((u32x2*)XM)[idx] = w;
        w.x = cvt_pk_bf16(b[0], b[1]); w.y = cvt_pk_bf16(b[2], b[3]); ((u32x2*)(XM + (size_t)M * D))[idx] = w;
        w.x = cvt_pk_bf16(c[0], c[1]); w.y = cvt_pk_bf16(c[2], c[3]); ((u32x2*)(XM + (size_t)2 * M * D))[idx] = w;
    }
}
__device__ __forceinline__ void ln_phase(const Ctx& C_unused, const bf16_t* src, const float* g, const float* b, float* of32, bf16_t* obf, float* stats) {
    const Ctx C = mkctx();
    u32x4 nx[4];
    if (C.gw < M) { const u32x4* xr = (const u32x4*)(src + (size_t)C.gw * D) + C.lane;
#pragma unroll
        for (int j = 0; j < 4; ++j) nx[j] = xr[64 * j]; }
    for (int m = C.gw; m < M; m += C.NGW) {
        f32x4 v[8]; float s = 0.f;
#pragma unroll
        for (int j = 0; j < 4; ++j) { v[2 * j] = (f32x4){bflo(nx[j].x), bfhi(nx[j].x), bflo(nx[j].y), bfhi(nx[j].y)}; v[2 * j + 1] = (f32x4){bflo(nx[j].z), bfhi(nx[j].z), bflo(nx[j].w), bfhi(nx[j].w)}; }
#pragma unroll
        for (int j = 0; j < 8; ++j) s += (v[j][0] + v[j][1]) + (v[j][2] + v[j][3]);
        if (m + C.NGW < M) { const u32x4* xr = (const u32x4*)(src + (size_t)(m + C.NGW) * D) + C.lane;
#pragma unroll
            for (int j = 0; j < 4; ++j) nx[j] = xr[64 * j]; }
        const float mean = wave_sum(s) * (1.f / D); float s2 = 0.f;
#pragma unroll
        for (int j = 0; j < 8; ++j) { v[j] = v[j] - mean; s2 += (v[j][0] * v[j][0] + v[j][1] * v[j][1]) + (v[j][2] * v[j][2] + v[j][3] * v[j][3]); }
        const float rstd = 1.0f / sqrtf(wave_sum(s2) * (1.f / D) + LN_EPS);
        if (stats && C.lane == 0) *(f32x2*)(stats + 2 * (size_t)m) = (f32x2){mean, rstd};
#pragma unroll
        for (int j = 0; j < 4; ++j) {
            const int ch = C.lane + 64 * j;
            const f32x4 ga = ((const f32x4*)g)[2 * ch], gb_ = ((const f32x4*)g)[2 * ch + 1], ba = ((const f32x4*)b)[2 * ch], bb = ((const f32x4*)b)[2 * ch + 1];
            const f32x4 o0 = v[2 * j] * rstd * ga + ba, o1 = v[2 * j + 1] * rstd * gb_ + bb;
            if (of32) { ((f32x4*)(of32 + (size_t)m * D))[2 * ch] = o0; ((f32x4*)(of32 + (size_t)m * D))[2 * ch + 1] = o1; }
            if (obf) { u32x4 w; w.x = cvt_pk_bf16(o0[0], o0[1]); w.y = cvt_pk_bf16(o0[2], o0[3]); w.z = cvt_pk_bf16(o1[0], o1[1]); w.w = cvt_pk_bf16(o1[2], o1[3]); ((u32x4*)(obf + (size_t)m * D))[ch] = w; }
        }
    }
}
__device__ __forceinline__ void convact_phase(const Ctx& C_unused, bf16_t* HF, const float* cw, const float* cb) {
    const Ctx C = mkctx();
    constexpr int TT = 32, NCB = FF / 512;
    const int nitems = (M / TT) * NCB;
    for (int it = C.gw; it < nitems; it += C.NGW) {
        const int cbk = it % NCB, tt = it / NCB, t0 = tt * TT, c0 = cbk * 512 + C.lane * 8;
        float w0[8], w1[8], w2[8], bs[8], g2[8], g1[8];
#pragma unroll
        for (int j = 0; j < 8; ++j) { w0[j] = cw[c0 + j]; w1[j] = cw[FF + c0 + j]; w2[j] = cw[2 * FF + c0 + j]; bs[j] = cb[c0 + j]; g2[j] = 0.f; g1[j] = 0.f; }
        if (t0 & (SEQ - 1)) {
            const u32x4 a = *(const u32x4*)(HF + (size_t)(t0 - 2) * FF2 + c0), b = *(const u32x4*)(HF + (size_t)(t0 - 1) * FF2 + c0);
            g2[0] = bflo(a.x); g2[1] = bfhi(a.x); g2[2] = bflo(a.y); g2[3] = bfhi(a.y); g2[4] = bflo(a.z); g2[5] = bfhi(a.z); g2[6] = bflo(a.w); g2[7] = bfhi(a.w);
            g1[0] = bflo(b.x); g1[1] = bfhi(b.x); g1[2] = bflo(b.y); g1[3] = bfhi(b.y); g1[4] = bflo(b.z); g1[5] = bfhi(b.z); g1[6] = bflo(b.w); g1[7] = bfhi(b.w);
        }
#pragma unroll 4
        for (int t = t0; t < t0 + TT; ++t) {
            const u32x4 gv = *(const u32x4*)(HF + (size_t)t * FF2 + c0), uv = *(const u32x4*)(HF + (size_t)t * FF2 + FF + c0);
            float g0[8], up[8], o[8];
            g0[0] = bflo(gv.x); g0[1] = bfhi(gv.x); g0[2] = bflo(gv.y); g0[3] = bfhi(gv.y); g0[4] = bflo(gv.z); g0[5] = bfhi(gv.z); g0[6] = bflo(gv.w); g0[7] = bfhi(gv.w);
            up[0] = bflo(uv.x); up[1] = bfhi(uv.x); up[2] = bflo(uv.y); up[3] = bfhi(uv.y); up[4] = bflo(uv.z); up[5] = bfhi(uv.z); up[6] = bflo(uv.w); up[7] = bfhi(uv.w);
#pragma unroll
            for (int j = 0; j < 8; ++j) { const float a = bs[j] + g2[j] * w0[j] + g1[j] * w1[j] + g0[j] * w2[j]; o[j] = a * sigmoidf_(a) * up[j]; g2[j] = g1[j]; g1[j] = g0[j]; }
            u32x4 w; w.x = cvt_pk_bf16(o[0], o[1]); w.y = cvt_pk_bf16(o[2], o[3]); w.z = cvt_pk_bf16(o[4], o[5]); w.w = cvt_pk_bf16(o[6], o[7]);
            *(u32x4*)(HF + (size_t)t * FF2 + FF + c0) = w;
        }
    }
}

__device__ __forceinline__ void convfix_phase(const Ctx& C_unused, bf16_t* ACT, const float* GS, const float* US, const float* cw, const float* cb) {
    const Ctx C = mkctx();
    const int gt = C.gw * 64 + C.lane, NT = C.NGW * 64;
    constexpr int C4 = FF / 4;
    for (int idx = gt; idx < 256 * 2 * C4; idx += NT) {
        const int c = 4 * (idx % C4), rr = (idx / C4) & 1, g = idx / (2 * C4);
        const bool first = (g & 63) == 0;
        const f32x4 z = (f32x4){0.f, 0.f, 0.f, 0.f};
        const f32x4 g0 = *(const f32x4*)(GS + ((size_t)g * 4 + rr) * FF + c);
        f32x4 g1, g2;
        if (rr == 0) { g1 = first ? z : *(const f32x4*)(GS + ((size_t)(g - 1) * 4 + 3) * FF + c); g2 = first ? z : *(const f32x4*)(GS + ((size_t)(g - 1) * 4 + 2) * FF + c); }
        else { g1 = *(const f32x4*)(GS + ((size_t)g * 4 + 0) * FF + c); g2 = first ? z : *(const f32x4*)(GS + ((size_t)(g - 1) * 4 + 3) * FF + c); }
        const f32x4 up = *(const f32x4*)(US + ((size_t)g * 2 + rr) * FF + c);
        const f32x4 w0 = *(const f32x4*)(cw + c), w1 = *(const f32x4*)(cw + FF + c), w2 = *(const f32x4*)(cw + 2 * FF + c), bs = *(const f32x4*)(cb + c);
        const f32x4 av = bs + w0 * g2 + w1 * g1 + w2 * g0;
        f32x4 o;
#pragma unroll
        for (int j = 0; j < 4; ++j) o[j] = av[j] * sigmoidf_(av[j]) * up[j];
        u32x2 w; w.x = cvt_pk_bf16(o[0], o[1]); w.y = cvt_pk_bf16(o[2], o[3]);
        *(u32x2*)(ACT + ((size_t)g * 64 + rr) * FF + c) = w;
    }
}

constexpr int TC = 32, SROW = 360;
struct ScanP { const bf16_t* R; const bf16_t* K; const bf16_t* V; const bf16_t* AA; const bf16_t* DEC; const float* k_k; const float* k_a; const float* r_k; bf16_t* Y; float* BONUS;
               const float* t_up; const float* t_dn; const float* t_wo; bf16_t* d_up; bf16_t* d_dn; bf16_t* d_wo;
               const float* t_up0; const float* t_dn0; const float* t_wo0; bf16_t* d_up0; bf16_t* d_dn0; bf16_t* d_wo0; };
constexpr int TW_I0 = (D / 64) * (FF2 / 32), TW_I1 = (FF / 64) * (D / 32), TW_I2 = (D / 64) * (D / 32), TW_HALF = TW_I0 + TW_I1 + TW_I2, TW_TOTAL = 2 * TW_HALF;
#define TW_DECODE(P, ti, SRC, DST, KK, NN, IT, RM) const bool l1_ = (ti) >= TW_HALF; const int t_ = l1_ ? (ti) - TW_HALF : (ti); \
    const int sg_ = (t_ < TW_I0) ? 0 : ((t_ < TW_I0 + TW_I1) ? 1 : 2); \
    const float* SRC = sg_ == 0 ? (l1_ ? (P).t_up : (P).t_up0) : (sg_ == 1 ? (l1_ ? (P).t_dn : (P).t_dn0) : (l1_ ? (P).t_wo : (P).t_wo0)); \
    bf16_t* DST = sg_ == 0 ? (l1_ ? (P).d_up : (P).d_up0) : (sg_ == 1 ? (l1_ ? (P).d_dn : (P).d_dn0) : (l1_ ? (P).d_wo : (P).d_wo0)); \
    const int KK = sg_ == 1 ? FF : D, NN = sg_ == 0 ? FF2 : D, IT = sg_ == 0 ? t_ : (sg_ == 1 ? t_ - TW_I0 : t_ - TW_I0 - TW_I1), RM = sg_ == 0 ? 1 : 0;
#define SCAN_LOADRAW(RR, KR, AR, DR, VR, tok_) do { const size_t t__ = (tok_); \
    RR = *(const u32x2*)(P.R + t__ * D + col); KR = *(const u32x2*)(P.K + t__ * D + col); AR = *(const u32x2*)(P.AA + t__ * D + col); \
    DR = *(const u32x2*)(P.DEC + t__ * D + col); VR = *(const unsigned*)(P.V + t__ * D + h * 64 + half * 32 + 2 * cl); } while (0)
#define SCAN_PREP(RR, KR, AR, DR, VR, tok_, buf_, step_) do { const size_t t__ = (tok_); \
    const f32x4 r = (f32x4){bflo(RR.x), bfhi(RR.x), bflo(RR.y), bfhi(RR.y)}; \
    const f32x4 k = (f32x4){bflo(KR.x), bfhi(KR.x), bflo(KR.y), bfhi(KR.y)}; \
    const f32x4 a = (f32x4){bflo(AR.x), bfhi(AR.x), bflo(AR.y), bfhi(AR.y)}; \
    const f32x4 dcy = (f32x4){__expf(bflo(DR.x)), __expf(bfhi(DR.x)), __expf(bflo(DR.y)), __expf(bfhi(DR.y))}; \
    const f32x4 kkr = k * kk4; \
    const float ss = red16((kkr[0] * kkr[0] + kkr[1] * kkr[1]) + (kkr[2] * kkr[2] + kkr[3] * kkr[3])); \
    const float inv = 1.0f / sqrtf(fmaxf(ss, 1e-24f)); \
    const f32x4 kk = kkr * inv; \
    const f32x4 kp = k * (1.0f + (a - 1.0f) * ka4); \
    const f32x4 bv = kk * a; \
    const float bon = red16((r[0] * kp[0] * rk4[0] + r[1] * kp[1] * rk4[1]) + (r[2] * kp[2] * rk4[2] + r[3] * kp[3] * rk4[3])); \
    LAS float* rec = inb + (buf_) * (TC * SROW) + (step_) * SROW; \
    *(LAS f32x4*)(rec + 4 * cl) = dcy; *(LAS f32x4*)(rec + 64 + 4 * cl) = -kk; *(LAS f32x4*)(rec + 128 + 4 * cl) = bv; \
    *(LAS f32x4*)(rec + 192 + 4 * cl) = kp; *(LAS f32x4*)(rec + 256 + 4 * cl) = r; \
    *(LAS f32x2*)(rec + 320 + 2 * cl) = (f32x2){bflo(VR), bfhi(VR)}; \
    if (cl == 0 && half == 0) P.BONUS[t__ * 32 + h] = bon; } while (0)
__device__ __forceinline__ void scan_phase(const ScanP P, LAS unsigned char* lds, int G) {
    LAS float* inb = (LAS float*)lds;
    LAS float* ybuf = (LAS float*)(lds + 2 * TC * SROW * 4);
    const int tid = opaque_tid();
    const bool helper = tid >= 256;
    const int ht = tid & 255, cl = ht & 15, hrw = ht >> 4;
    const int c8 = tid & 7, r8 = (tid >> 3) & 31;
    for (int item = blockIdx.x; item < 256; item += G) {
        const int bh = item >> 1, half = item & 1, bt = bh >> 5, h = bh & 31;
        const int col = h * 64 + 4 * cl;
        const size_t tok0 = (size_t)bt * SEQ;
        f32x4 kk4 = (f32x4){0.f, 0.f, 0.f, 0.f}, ka4 = kk4, rk4 = kk4;
        u32x2 rA_ = (u32x2){0u, 0u}, kA_ = rA_, aA_ = rA_, rB_ = rA_, kB_ = rA_, aB_ = rA_, dA_ = rA_, dB_ = rA_; unsigned vA_ = 0u, vB_ = 0u;
        float tv[32]; int tpend = -1;
#pragma unroll
        for (int i = 0; i < 32; ++i) tv[i] = 0.f;
        if (helper) {
            kk4 = *(const f32x4*)(P.k_k + col); ka4 = *(const f32x4*)(P.k_a + col); rk4 = *(const f32x4*)(P.r_k + col);
            SCAN_LOADRAW(rA_, kA_, aA_, dA_, vA_, tok0 + hrw); SCAN_LOADRAW(rB_, kB_, aB_, dB_, vB_, tok0 + hrw + 16);
            SCAN_PREP(rA_, kA_, aA_, dA_, vA_, tok0 + hrw, 0, hrw); SCAN_PREP(rB_, kB_, aB_, dB_, vB_, tok0 + hrw + 16, 0, hrw + 16);
            SCAN_LOADRAW(rA_, kA_, aA_, dA_, vA_, tok0 + TC + hrw); SCAN_LOADRAW(rB_, kB_, aB_, dB_, vB_, tok0 + TC + hrw + 16);
        }
        f32x2 S01 = (f32x2){0.f, 0.f}, S23 = (f32x2){0.f, 0.f}, S45 = (f32x2){0.f, 0.f}, S67 = (f32x2){0.f, 0.f};
        __syncthreads();
        for (int c = 0; c < SEQ / TC; ++c) {
            const int buf = c & 1;
            if (helper) {
                if (c > 0) {
                    const int tt = ht >> 3, rq = ht & 7;
                    const f32x4 yv = *(const LAS f32x4*)(ybuf + (buf ^ 1) * (TC * 32) + tt * 32 + 4 * rq);
                    u32x2 yw; yw.x = cvt_pk_bf16(yv[0], yv[1]); yw.y = cvt_pk_bf16(yv[2], yv[3]);
                    *(u32x2*)(P.Y + (tok0 + (c - 1) * TC + tt) * D + h * 64 + half * 32 + 4 * rq) = yw;
                }
                if (c + 1 < SEQ / TC) {
                    SCAN_PREP(rA_, kA_, aA_, dA_, vA_, tok0 + (c + 1) * TC + hrw, buf ^ 1, hrw); SCAN_PREP(rB_, kB_, aB_, dB_, vB_, tok0 + (c + 1) * TC + hrw + 16, buf ^ 1, hrw + 16);
                    if (c + 2 < SEQ / TC) { SCAN_LOADRAW(rA_, kA_, aA_, dA_, vA_, tok0 + (c + 2) * TC + hrw); SCAN_LOADRAW(rB_, kB_, aB_, dB_, vB_, tok0 + (c + 2) * TC + hrw + 16); }
                }
                LAS float* scr = (LAS float*)(lds + 2 * TC * SROW * 4 + 2 * TC * 32 * 4 + ((tid >> 6) - 4) * 8448);
                const int ln = tid & 63;
                if (tpend >= 0) { TW_DECODE(P, tpend, src_, dst_, kk_, nn_, it_, rm_); (void)src_; titem_finish(kk_, nn_, dst_, scr, it_, ln, rm_, tv); }
                const int q = ((item - (int)blockIdx.x) / G) * (SEQ / TC) + c;
                const int ti = q * (G * 4) + (int)blockIdx.x * 4 + ((tid >> 6) - 4);
                tpend = -1;
                if (ti < TW_TOTAL) { tpend = ti; TW_DECODE(P, ti, src_, dst_, kk_, nn_, it_, rm_); (void)dst_; (void)kk_; (void)rm_; titem_issue(src_, nn_, it_, ln, tv); }
            } else {
                const LAS float* rb = inb + buf * (TC * SROW) + 8 * c8;
                const LAS float* vb = inb + buf * (TC * SROW) + 320 + r8;
                LAS float* yb = ybuf + buf * (TC * 32) + r8;
                f32x4 wA = *(const LAS f32x4*)(rb), wB = *(const LAS f32x4*)(rb + 4), nA = *(const LAS f32x4*)(rb + 64), nB = *(const LAS f32x4*)(rb + 68);
                f32x4 bA = *(const LAS f32x4*)(rb + 128), bB = *(const LAS f32x4*)(rb + 132), kA = *(const LAS f32x4*)(rb + 192), kB = *(const LAS f32x4*)(rb + 196);
                f32x4 rA = *(const LAS f32x4*)(rb + 256), rB = *(const LAS f32x4*)(rb + 260);
                float vv = vb[0];
                float ykeep = 0.f; float qa[8];
                const bool b0 = (c8 & 1) != 0, b1 = (c8 & 2) != 0, b2 = (c8 & 4) != 0;
#pragma unroll
                for (int tt = 0; tt < TC; ++tt) {
                    f32x4 wAn = wA, wBn = wB, nAn = nA, nBn = nB, bAn = bA, bBn = bB, kAn = kA, kBn = kB, rAn = rA, rBn = rB; float vvn = vv;
                    if (tt + 1 < TC) { const LAS float* rn = rb + (tt + 1) * SROW;
                        wAn = *(const LAS f32x4*)(rn); wBn = *(const LAS f32x4*)(rn + 4); nAn = *(const LAS f32x4*)(rn + 64); nBn = *(const LAS f32x4*)(rn + 68);
                        bAn = *(const LAS f32x4*)(rn + 128); bBn = *(const LAS f32x4*)(rn + 132); kAn = *(const LAS f32x4*)(rn + 192); kBn = *(const LAS f32x4*)(rn + 196);
                        rAn = *(const LAS f32x4*)(rn + 256); rBn = *(const LAS f32x4*)(rn + 260); vvn = vb[(tt + 1) * SROW]; }
                    __builtin_amdgcn_sched_barrier(0);
                    f32x2 p = S01 * nA.lo, p2 = S45 * nB.lo; p = S23 * nA.hi + p; p2 = S67 * nB.hi + p2; p = p + p2;
                    const float sa = red8(p.x + p.y);
                    f32x2 t01 = kA.lo * vv, t23 = kA.hi * vv, t45 = kB.lo * vv, t67 = kB.hi * vv;
                    t01 = bA.lo * sa + t01; t23 = bA.hi * sa + t23; t45 = bB.lo * sa + t45; t67 = bB.hi * sa + t67;
                    S01 = S01 * wA.lo + t01; S23 = S23 * wA.hi + t23; S45 = S45 * wB.lo + t45; S67 = S67 * wB.hi + t67;
                    f32x2 q = S01 * rA.lo, q2 = S45 * rB.lo; q = S23 * rA.hi + q; q2 = S67 * rB.hi + q2; q = q + q2;
                    qa[tt & 7] = q.x + q.y;
                    if ((tt & 7) == 7) {
                        float r4[4], r2[2];
#pragma unroll
                        for (int i = 0; i < 4; ++i) { const float keep = b0 ? qa[2 * i + 1] : qa[2 * i], send = b0 ? qa[2 * i] : qa[2 * i + 1]; r4[i] = keep + dppf<0xB1>(send); }
#pragma unroll
                        for (int i = 0; i < 2; ++i) { const float keep = b1 ? r4[2 * i + 1] : r4[2 * i], send = b1 ? r4[2 * i] : r4[2 * i + 1]; r2[i] = keep + dppf<0x4E>(send); }
                        const float keep = b2 ? r2[1] : r2[0], send = b2 ? r2[0] : r2[1];
                        ykeep = keep + __shfl_xor(send, 4);
                        yb[(tt - 7 + c8) * 32] = ykeep;
                    }
                    __builtin_amdgcn_sched_barrier(0);
                    wA = wAn; wB = wBn; nA = nAn; nB = nBn; bA = bAn; bB = bBn; kA = kAn; kB = kBn; rA = rAn; rB = rBn; vv = vvn;
                }
            }
            __syncthreads();
        }
        if (helper) {
            {   const int c = SEQ / TC - 1, tt = ht >> 3, rq = ht & 7;
                const f32x4 yv = *(const LAS f32x4*)(ybuf + (c & 1) * (TC * 32) + tt * 32 + 4 * rq);
                u32x2 yw; yw.x = cvt_pk_bf16(yv[0], yv[1]); yw.y = cvt_pk_bf16(yv[2], yv[3]);
                *(u32x2*)(P.Y + (tok0 + c * TC + tt) * D + h * 64 + half * 32 + 4 * rq) = yw; }
            if (tpend >= 0) {
                LAS float* scr = (LAS float*)(lds + 2 * TC * SROW * 4 + 2 * TC * 32 * 4 + ((tid >> 6) - 4) * 8448);
                const int ln = tid & 63;
                TW_DECODE(P, tpend, src_, dst_, kk_, nn_, it_, rm_); (void)src_; titem_finish(kk_, nn_, dst_, scr, it_, ln, rm_, tv);
            }
        }
        __syncthreads();
    }
}
#undef SCAN_LOADRAW
#undef SCAN_PREP
__device__ __forceinline__ void post_phase(const Ctx& C_unused, const bf16_t* Y, const bf16_t* V, const bf16_t* Gt, const float* BONUS, const float* gn_g, const float* gn_b, bf16_t* YG) {
    const Ctx C = mkctx();
    const int gt = C.gw * 64 + C.lane, NT = C.NGW * 64;
    for (int idx = gt; idx < M * (D / 4); idx += NT) {
        const int t = idx >> 9, c4 = idx & 511, h = c4 >> 4;
        const u32x2 yr = ((const u32x2*)Y)[idx];
        const f32x4 y = (f32x4){bflo(yr.x), bfhi(yr.x), bflo(yr.y), bfhi(yr.y)};
        const float mean = red16((y[0] + y[1]) + (y[2] + y[3])) * (1.f / 64.f);
        const f32x4 dlt = y - mean;
        const float var = red16((dlt[0] * dlt[0] + dlt[1] * dlt[1]) + (dlt[2] * dlt[2] + dlt[3] * dlt[3])) * (1.f / 64.f);
        const float rstd = 1.0f / sqrtf(var + GN_EPS);
        const f32x4 gg = ((const f32x4*)gn_g)[c4], gb = ((const f32x4*)gn_b)[c4];
        const u32x2 vr = ((const u32x2*)V)[idx], gr = ((const u32x2*)Gt)[idx];
        const f32x4 v = (f32x4){bflo(vr.x), bfhi(vr.x), bflo(vr.y), bfhi(vr.y)}, gate = (f32x4){bflo(gr.x), bfhi(gr.x), bflo(gr.y), bfhi(gr.y)};
        const float bon = BONUS[(size_t)t * 32 + h];
        const f32x4 o = (dlt * rstd * gg + gb + v * bon) * gate;
        u32x2 w; w.x = cvt_pk_bf16(o[0], o[1]); w.y = cvt_pk_bf16(o[2], o[3]); ((u32x2*)YG)[idx] = w;
    }
}

constexpr int KROWB = 272;
constexpr int VT_OFF = 256 * KROWB;
__device__ __forceinline__ void attn_phase(const bf16_t* QKV, bf16_t* OG, float* LSE, int dil, LAS unsigned char* lds, int G, int accum) {
    const int tid = opaque_tid(), lane = tid & 63, wave0 = __builtin_amdgcn_readfirstlane(tid >> 6), fr = lane & 15, fq = lane >> 4;
    const int nb = 32 / dil, RL = nb < 4 ? nb : 4, rpc = nb / RL, nitems = 2048 / RL;
    const int krow = tid >> 4, kch = tid & 15;
    const int vdch = tid >> 5, vkq = tid & 31;
    const int vcu = (G % 8 == 0) ? ((int)blockIdx.x % 8) * (G / 8) + (int)blockIdx.x / 8 : (int)blockIdx.x;
    for (int item = vcu; item < nitems; item += G) {
        int wave = wave0; asm volatile("" : "+v"(wave));
        const int chain = item / rpc, run = item - chain * rpc;
        const int r = chain % dil, h = (chain / dil) & 15, bt = chain / (dil * 16);
        const int n0 = run * RL;
        const size_t tok0 = (size_t)bt * SEQ;
        const bf16_t* kbase = QKV + 2048 + h * 128 + kch * 8;
        const bf16_t* vbase = QKV + 4096 + h * 128 + vdch * 8;
        u32x4 kreg[4], vreg[4]; bf16x8 qn[4];
#define AT_LOAD(nn) do { _Pragma("unroll") for (int it = 0; it < 4; ++it) { const int pos = ((nn) * 128 + krow + 32 * it) * dil + r; kreg[it] = *(const u32x4*)(kbase + (tok0 + pos) * NQKV); } \
        _Pragma("unroll") for (int j = 0; j < 4; ++j) { const int pos = ((nn) * 128 + 4 * vkq + j) * dil + r; vreg[j] = *(const u32x4*)(vbase + (tok0 + pos) * NQKV); } } while (0)
#define AT_STORE(slot) do { _Pragma("unroll") for (int it = 0; it < 4; ++it) *(LAS u32x4*)(lds + ((slot) * 128 + krow + 32 * it) * KROWB + kch * 16) = kreg[it]; \
        _Pragma("unroll") for (int i = 0; i < 8; ++i) { unsigned e0, e1, e2, e3; \
            if (i & 1) { e0 = vreg[0][i >> 1] >> 16; e1 = vreg[1][i >> 1] >> 16; e2 = vreg[2][i >> 1] >> 16; e3 = vreg[3][i >> 1] >> 16; } \
            else { e0 = vreg[0][i >> 1] & 0xffffu; e1 = vreg[1][i >> 1] & 0xffffu; e2 = vreg[2][i >> 1] & 0xffffu; e3 = vreg[3][i >> 1] & 0xffffu; } \
            u32x2 w_; w_.x = e0 | (e1 << 16); w_.y = e2 | (e3 << 16); \
            *(LAS u32x2*)(lds + VT_OFF + (8 * vdch + i) * 512 + ((((slot) * 32 + vkq) ^ (4 * i)) * 8)) = w_; } } while (0)
#define AT_LOADQ(nn) do { const size_t qt_ = tok0 + (size_t)(((nn) * 128 + 16 * wave + fr) * dil + r); \
        _Pragma("unroll") for (int ks = 0; ks < 4; ++ks) qn[ks] = *(const bf16x8*)(QKV + qt_ * NQKV + h * 128 + 32 * ks + 8 * fq); } while (0)
        if (n0 > 0) { AT_LOAD(n0 - 1); }
        else {
#pragma unroll
            for (int j = 0; j < 4; ++j) { kreg[j] = (u32x4){0u, 0u, 0u, 0u}; vreg[j] = (u32x4){0u, 0u, 0u, 0u}; } }
        AT_STORE((n0 & 1) ^ 1);
        AT_LOAD(n0); AT_LOADQ(n0);
        for (int n = n0; n < n0 + RL; ++n) {
            asm volatile("" : "+v"(wave));
            AT_STORE(n & 1);
            bf16x8 qf[4];
#pragma unroll
            for (int ks = 0; ks < 4; ++ks) qf[ks] = qn[ks];
            __syncthreads();
            if (n + 1 < n0 + RL) { AT_LOAD(n + 1); AT_LOADQ(n + 1); }
            const int flip = (n & 1) ^ 1;
            const int qi = 16 * wave + fr;
            const size_t qtok = tok0 + (size_t)((n * 128 + qi) * dil + r);
            f32x4 sc[10];
#pragma unroll
            for (int tt = 0; tt < 10; ++tt) {
                const int tile = ((wave + tt) < 15 ? (wave + tt) : 15) ^ (8 * flip);
                f32x4 acc = (f32x4){0.f, 0.f, 0.f, 0.f};
#pragma unroll
                for (int ks = 0; ks < 4; ++ks) {
                    const bf16x8 kf = *(const LAS bf16x8*)(lds + (16 * tile + fr) * KROWB + 64 * ks + 16 * fq);
                    acc = __builtin_amdgcn_mfma_f32_16x16x32_bf16(kf, qf[ks], acc, 0, 0, 0);
                }
                sc[tt] = acc;
            }
            constexpr float SC2 = 0.08838834764831845f * 1.4426950408889634f;
            float mx = -3.0e38f;
#pragma unroll
            for (int tt = 0; tt < 10; ++tt) {
                const bool tile_ok = (wave + tt <= 15) && (n > 0 || (wave + tt) >= 8);
#pragma unroll
                for (int j = 0; j < 4; ++j) {
                    bool valid = tile_ok;
                    if (tt == 0 || tt >= 8) { const int kj = 16 * (wave + tt) + 4 * fq + j; valid = valid && (kj >= qi) && (kj <= qi + 128); }
                    const float s = valid ? sc[tt][j] * SC2 : -1e30f;
                    sc[tt][j] = s; mx = fmaxf(mx, s);
                }
            }
            mx = fmaxf(mx, __shfl_xor(mx, 16)); mx = fmaxf(mx, __shfl_xor(mx, 32));
            float sum = 0.f;
#pragma unroll
            for (int tt = 0; tt < 10; ++tt)
#pragma unroll
                for (int j = 0; j < 4; ++j) { const float p = __builtin_amdgcn_exp2f(sc[tt][j] - mx); sc[tt][j] = p; sum += p; }
            sum += __shfl_xor(sum, 16); sum += __shfl_xor(sum, 32);
            bf16x8 pf[5];
#pragma unroll
            for (int s = 0; s < 5; ++s) {
                u32x4 w; w.x = cvt_pk_bf16(sc[2 * s][0], sc[2 * s][1]); w.y = cvt_pk_bf16(sc[2 * s][2], sc[2 * s][3]);
                w.z = cvt_pk_bf16(sc[2 * s + 1][0], sc[2 * s + 1][1]); w.w = cvt_pk_bf16(sc[2 * s + 1][2], sc[2 * s + 1][3]);
                pf[s] = __builtin_bit_cast(bf16x8, w);
            }
            const float inv = 1.0f / sum;
            bf16_t* orow = OG + qtok * D + h * 128 + 4 * fq;
            const float lse_g = (mx + __builtin_amdgcn_logf(sum)) * 0.6931471805599453f;
            float w_old = 0.f, w_new = inv, lse_out = lse_g;
            u32x2 oldv[8];
            if (accum) {
#pragma unroll
                for (int dt = 0; dt < 8; ++dt) oldv[dt] = *(const u32x2*)(orow + 16 * dt);
                const float lse_o = LSE[qtok * 16 + h];
                const float mxl = fmaxf(lse_o, lse_g), eo = __expf(lse_o - mxl), en = __expf(lse_g - mxl), rden = 1.0f / (eo + en);
                w_old = eo * rden; w_new = en * rden * inv; lse_out = mxl + __logf(eo + en);
            }
#pragma unroll
            for (int dt = 0; dt < 8; ++dt) {
                f32x4 o = (f32x4){0.f, 0.f, 0.f, 0.f};
                const LAS unsigned char* vrow = lds + VT_OFF + (16 * dt + fr) * 512;
                const int sw = 4 * (fr & 7);
#pragma unroll
                for (int s = 0; s < 5; ++s) {
                    const int tA = ((wave + 2 * s) < 15 ? (wave + 2 * s) : 15) ^ (8 * flip), tB = ((wave + 2 * s + 1) < 15 ? (wave + 2 * s + 1) : 15) ^ (8 * flip);
                    const u32x2 va = *(const LAS u32x2*)(vrow + (((4 * tA + fq) ^ sw) * 8)), vb = *(const LAS u32x2*)(vrow + (((4 * tB + fq) ^ sw) * 8));
                    const u32x4 vv = (u32x4){va.x, va.y, vb.x, vb.y};
                    o = __builtin_amdgcn_mfma_f32_16x16x32_bf16(__builtin_bit_cast(bf16x8, vv), pf[s], o, 0, 0, 0);
                }
                f32x4 r = o * w_new;
                if (accum) r = r + (f32x4){bflo(oldv[dt].x), bfhi(oldv[dt].x), bflo(oldv[dt].y), bfhi(oldv[dt].y)} * w_old;
                u32x2 w; w.x = cvt_pk_bf16(r[0], r[1]); w.y = cvt_pk_bf16(r[2], r[3]);
                *(u32x2*)(orow + 16 * dt) = w;
            }
            if (fq == 0) LSE[qtok * 16 + h] = lse_out;
            __syncthreads();
        }
#undef AT_LOAD
#undef AT_STORE
#undef AT_LOADQ
    }
}
__device__ __forceinline__ void merge_phase(const Ctx& C_unused, const bf16_t* OG, const float* LSE, bf16_t* OM) {
    const Ctx C = mkctx();
    const int gt = C.gw * 64 + C.lane, NT = C.NGW * 64;
    for (int idx = gt; idx < M * (D / 8); idx += NT) {
        const int t = idx >> 8, c8 = idx & 255, h = c8 >> 4;
        const float l0 = LSE[(size_t)t * 16 + h], l1 = LSE[(size_t)(M + t) * 16 + h], l2 = LSE[(size_t)(2 * M + t) * 16 + h];
        const float mx = fmaxf(l0, fmaxf(l1, l2));
        float w0 = __expf(l0 - mx), w1 = __expf(l1 - mx), w2 = __expf(l2 - mx);
        const float inv = 1.0f / (w0 + w1 + w2); w0 *= inv; w1 *= inv; w2 *= inv;
        const u32x4 a = ((const u32x4*)OG)[idx], b = ((const u32x4*)(OG + (size_t)M * D))[idx], c = ((const u32x4*)(OG + (size_t)2 * M * D))[idx];
        u32x4 o;
#pragma unroll
        for (int j = 0; j < 4; ++j) {
            const float lo = w0 * bflo(a[j]) + w1 * bflo(b[j]) + w2 * bflo(c[j]);
            const float hi = w0 * bfhi(a[j]) + w1 * bfhi(b[j]) + w2 * bfhi(c[j]);
            o[j] = cvt_pk_bf16(lo, hi);
        }
        ((u32x4*)OM)[idx] = o;
    }
}

#define XB_TMO      128
#define XB_XCNT(j)  (256  + 64 * (j))
#define XB_XSUB(j)  (1280 + 64 * (j))
#define XB_XGEN(j)  (2304 + 64 * (j))
#define XB_TOP      3328
#define XB_TOPGEN   3392
#define XCD_BAR_WORDS 3456
#define XB_SPIN_CAP (1u << 18)
constexpr size_t O_BAR = 512 * 1024;
__device__ __forceinline__ unsigned xb_ld(unsigned* p)              { return __hip_atomic_load(p, __ATOMIC_RELAXED, __HIP_MEMORY_SCOPE_AGENT); }
__device__ __forceinline__ unsigned xb_add(unsigned* p, unsigned v) { return __hip_atomic_fetch_add(p, v, __ATOMIC_RELAXED, __HIP_MEMORY_SCOPE_AGENT); }
__device__ __forceinline__ unsigned xb_xcc_id() { return (unsigned)__builtin_amdgcn_s_getreg((3 << 11) | 20) & 0xFu; }
#define XB_SPIN(cond, bar) do { unsigned _sp = 0; while (cond) { __builtin_amdgcn_s_sleep(1); \
    if ((++_sp & 255u) == 0u) { if (xb_ld(&(bar)[XB_TMO])) break; if (_sp > XB_SPIN_CAP) { atomicAdd(&(bar)[XB_TMO], 1u); break; } } } } while (0)
struct XcdBarrier { unsigned* bar; unsigned x; volatile LAS unsigned* st; };
__device__ __forceinline__ XcdBarrier xcd_barrier_post(unsigned* bar, volatile LAS unsigned* st) {
    XcdBarrier b; b.bar = bar; b.x = xb_xcc_id(); b.st = st;
    if (threadIdx.x == 0) (void)xb_add(&bar[XB_XCNT(b.x)], 1u);
    return b;
}
__device__ __forceinline__ void xcd_barrier_complete(unsigned* bar, unsigned x, unsigned& nloc, unsigned& nx) {
    const unsigned G = gridDim.x * gridDim.y * gridDim.z;
    unsigned sum, cnt, mine, sp = 0u;
    for (;;) {
        sum = 0u; cnt = 0u; mine = 0u;
#pragma unroll
        for (unsigned j = 0; j < 16; ++j) { const unsigned c = xb_ld(&bar[XB_XCNT(j)]); sum += c; cnt += (c > 0u) ? 1u : 0u; mine = (j == x) ? c : mine; }
        if (sum == G) break;
        __builtin_amdgcn_s_sleep(1);
        if ((++sp & 255u) == 0u) { if (xb_ld(&bar[XB_TMO])) break; if (sp > XB_SPIN_CAP) { atomicAdd(&bar[XB_TMO], 1u); break; } }
    }
    nloc = mine > 0u ? mine : 1u; nx = cnt > 0u ? cnt : 1u;
}
__device__ __forceinline__ void xcd_barrier(const XcdBarrier& b) {
    asm volatile("s_waitcnt vmcnt(0)" ::: "memory");
    __syncthreads();
    if (threadIdx.x == 0) {
        unsigned* bar = b.bar;
        __builtin_amdgcn_s_waitcnt(0);
        unsigned nloc = b.st[0], nx = b.st[1];
        if (nloc == 0u) { xcd_barrier_complete(bar, b.x, nloc, nx); b.st[0] = nloc; b.st[1] = nx; }
        const unsigned old = xb_add(&bar[XB_XSUB(b.x)], 1u);
        const unsigned gen = old / nloc;
        if (old + 1u == (gen + 1u) * nloc) {
            __builtin_amdgcn_fence(__ATOMIC_RELEASE, "agent");
            asm volatile("s_waitcnt vmcnt(0)" ::: "memory");
            const unsigned og = xb_add(&bar[XB_TOP], 1u);
            const unsigned tg = og / nx;
            if (og + 1u == (tg + 1u) * nx) xb_add(&bar[XB_TOPGEN], 1u);
            else XB_SPIN(xb_ld(&bar[XB_TOPGEN]) == tg, bar);
            __builtin_amdgcn_fence(__ATOMIC_ACQUIRE, "agent");
            xb_add(&bar[XB_XGEN(b.x)], 1u);
            asm volatile("s_waitcnt vmcnt(0)" ::: "memory");
        } else {
            XB_SPIN(xb_ld(&bar[XB_XGEN(b.x)]) == gen, bar);
            __builtin_amdgcn_fence(__ATOMIC_ACQUIRE, "agent");
            asm volatile("s_waitcnt vmcnt(0)" ::: "memory");
        }
    }
    __syncthreads();
}
__device__ __forceinline__ void seam_barrier(unsigned char* wsp, LAS unsigned char* lds) {
    XcdBarrier b; b.bar = (unsigned*)(wsp + O_BAR); b.x = xb_xcc_id(); b.st = (volatile LAS unsigned*)(lds + LDS_BYTES - 16);
    xcd_barrier(b);
}

__global__ void __launch_bounds__(512, 2) mega(Args args) {
    extern __shared__ __attribute__((aligned(16))) unsigned char smem[];
    LAS unsigned char* lds = (LAS unsigned char*)smem;
    cg::grid_group grid = cg::this_grid();
    if (threadIdx.x < 4) ((LAS unsigned*)(lds + LDS_BYTES - 16))[threadIdx.x] = 0u;
    __syncthreads();
    (void)xcd_barrier_post((unsigned*)(arg_ws() + O_BAR), (volatile LAS unsigned*)(lds + LDS_BYTES - 16));
    Ctx C; C.tid = threadIdx.x; C.lane = C.tid & 63; C.wave = __builtin_amdgcn_readfirstlane(C.tid >> 6); C.G = gridDim.x; C.gw = blockIdx.x * 8 + C.wave; C.NGW = C.G * 8;
#ifndef ENMASK
#define ENMASK 0xFFFFFFFFu
#endif
#define ws (arg_ws())
#define out (arg_out())
#define IN(k) (((ENMASK >> ((k) > 21 ? (k) - 13 : (k))) & 1u) && arg_int(232) <= (k) && (k) < arg_int(236))
#define SEAM(k) do { if (IN(k) && IN((k) + 1)) { if (arg_int(236) > 4096) grid.sync(); seam_barrier(ws, lds); } } while (0)
#ifndef REPMASK
#define REPMASK 0u
#endif
#define REPS(k) (((REPMASK >> (k)) & 1u) ? 2 : 1)
#define BT1 ((bf16_t*)(ws + O_BT1))
#define BT2 ((bf16_t*)(ws + O_BT2))
#define WOR ((bf16_t*)(ws + O_WOR))
#define WUP0 ((bf16_t*)(ws + O_WUP0))
#define WDN0 ((bf16_t*)(ws + O_WDN0))
#define Hb ((bf16_t*)(ws + O_H))
#define XM ((bf16_t*)(ws + O_XM))
#define DEC ((float*)(ws + O_DEC))
#define AA ((bf16_t*)(ws + O_AA))
#define RKV ((bf16_t*)(ws + O_RKV))
#define Gt ((bf16_t*)(ws + O_G))
#define BONUS ((float*)(ws + O_BONUS))
#define YG ((bf16_t*)(ws + O_YG))
#define STATS ((float*)ws)
#define RESB ((bf16_t*)(ws + O_RES))

    if (IN(0)) for (int rep = 0; rep < REPS(0); ++rep) {
        if (rep) grid.sync();
        for (int c = 0; c < 3; ++c) transpose_mat(C, lds, arg_in(2) + (size_t)c * D * D, D, D, BT1 + (size_t)c * D * D);
        transpose_mat(C, lds, arg_in(4), D, 96, BT1 + (size_t)6144 * D);
        zero_fill16(C, BT1 + (size_t)(6144 + 96) * D, (size_t)160 * D * 2 / 16);
        transpose_mat(C, lds, arg_in(7), D, 96, BT1 + (size_t)6400 * D);
        zero_fill16(C, BT1 + (size_t)(6400 + 96) * D, (size_t)160 * D * 2 / 16);
        transpose_mat(C, lds, arg_in(9), D, 256, BT1 + (size_t)6656 * D);
        transpose_pad96(C, arg_in(5), BT2);
        transpose_pad96(C, arg_in(8), BT2 + (size_t)2048 * 256);
        transpose_mat(C, lds, arg_in(10), 256, D, BT2 + (size_t)4096 * 256);
        mix_phase(C, arg_in(0), arg_in(1), 0, 2, 3, XM);
    }
    SEAM(0);
    if (IN(1)) {
        pg8::Gemm g{XM, BT1, D, D, D}; pg8::Order S; S.init(64, 8, 3, 64, C.G, (int)blockIdx.x);
        pg8::Epi<0> E{{RKV, nullptr, nullptr, nullptr, nullptr, (size_t)M * D, D, 8}};
        pg8::gemm_phase(lds, g, S, E);
    }
    SEAM(1);
    if (IN(2)) mix_phase(C, arg_in(0), arg_in(1), 1, 4, 5, XM);
    SEAM(2);
    if (IN(3)) {
        pg8::Gemm g{XM, BT1 + (size_t)6144 * D, D, D, D}; pg8::Order S; S.init(64, 1, 3, 64, C.G, (int)blockIdx.x);
        pg8::Epi<1> E{{Hb, nullptr, nullptr, nullptr, nullptr, (size_t)M * 256, 256, 1}};
        pg8::gemm_phase(lds, g, S, E);
    }
    SEAM(3);
    if (IN(4)) {
        pg8::Gemm g{Hb, BT2, 256, 256, 256}; pg8::Order S; S.init(64, 8, 3, 64, C.G, (int)blockIdx.x);
        pg8::Epi<2> E{{DEC, AA, Gt, arg_in(3), arg_in(6), 0, D, 8}};
        pg8::gemm_phase(lds, g, S, E);
    }
    SEAM(4);
    if (IN(5)) {
        ScanP P{RKV, RKV + (size_t)M * D, RKV + (size_t)2 * M * D, AA, (const bf16_t*)DEC, arg_in(11), arg_in(12), arg_in(13), (bf16_t*)out, BONUS,
                arg_in(19) + (size_t)D * FF2, arg_in(22) + (size_t)FF * D, arg_in(18), (bf16_t*)(ws + O_WUP1), (bf16_t*)(ws + O_WDN1), (bf16_t*)(ws + O_WOA),
                arg_in(19), arg_in(22), arg_in(16), WUP0, WDN0, WOR};
        for (int rep = 0; rep < REPS(5); ++rep) { if (rep) grid.sync(); scan_phase(P, lds, C.G); }
    }
    SEAM(5);
    if (IN(6)) post_phase(C, (const bf16_t*)out, RKV + (size_t)2 * M * D, Gt, BONUS, arg_in(14), arg_in(15), YG);
    SEAM(6);
    if (IN(7)) {
        pg8::Gemm g{YG, WOR, D, D, D}; pg8::Order S; S.init(64, 8, 1, 0, C.G, (int)blockIdx.x);
        pg8::Epi<3> E{{RESB, nullptr, nullptr, arg_in(0), nullptr, 0, D, 8}};
        pg8::gemm_phase(lds, g, S, E);
    }
    SEAM(7);
    if (IN(8)) ln_phase(C, RESB, arg_in(23), arg_in(24), nullptr, (bf16_t*)(ws + O_X1B), STATS);
    SEAM(8);
#pragma unroll 1
    for (int L = 0; L < 2; ++L) {
        const int pb = L == 0 ? 9 : 22;
        bf16_t* HF = (bf16_t*)(ws + (L == 0 ? O_HF0 : O_HF1));
        const bf16_t* XB = (const bf16_t*)(ws + (L == 0 ? O_X1B : O_X3B));
        const bf16_t* WUP = (const bf16_t*)(ws + (L == 0 ? O_WUP0 : O_WUP1));
        const bf16_t* WDN = (const bf16_t*)(ws + (L == 0 ? O_WDN0 : O_WDN1));
        if (L == 1) {
            bf16_t* X2B = (bf16_t*)(ws + O_X2B); bf16_t* WIN = (bf16_t*)(ws + O_WIN); bf16_t* WOA = (bf16_t*)(ws + O_WOA);
            bf16_t* QKV = (bf16_t*)(ws + O_QKV); bf16_t* OG = (bf16_t*)(ws + O_OG); float* LSE = (float*)(ws + O_LSE); bf16_t* OM = (bf16_t*)(ws + O_OM);
#pragma unroll 1
            for (int gi = 0; gi < 3; ++gi) {
                if (IN(13 + 2 * gi)) {
                    pg8::Gemm g{X2B, WIN + (size_t)gi * NQKV * D, D, D, D}; pg8::Order S; S.init(64, 24, 1, 0, C.G, (int)blockIdx.x);
                    pg8::Epi<0> E{{QKV, nullptr, nullptr, nullptr, nullptr, 0, NQKV, 24}};
                    pg8::gemm_phase(lds, g, S, E);
                }
                SEAM(13 + 2 * gi);
                if (IN(14 + 2 * gi)) attn_phase(QKV, OG, LSE, gi == 0 ? 1 : (gi == 1 ? 4 : 16), lds, C.G, gi > 0 ? 1 : 0);
                if (gi < 2) SEAM(14 + 2 * gi); else { if (IN(18) && IN(20)) seam_barrier(ws, lds); }
            }
            if (IN(20)) {
                pg8::Gemm g{OG, WOA, D, D, D}; pg8::Order S; S.init(64, 8, 1, 0, C.G, (int)blockIdx.x);
                pg8::Epi<4> E{{RESB, STATS, nullptr, arg_in(25), arg_in(26), 0, D, 8}};
                pg8::gemm_phase(lds, g, S, E);
            }
            SEAM(20);
            if (IN(21)) {
                ln_phase(C, RESB, arg_in(23) + D, arg_in(24) + D, nullptr, (bf16_t*)(ws + O_X3B), STATS);
            }
            SEAM(21);
        }
        if (IN(pb)) {
            pg8::Gemm g{XB, WUP, D, D, D}; pg8::Order S; S.init(64, 44, 1, 0, C.G, (int)blockIdx.x);
            pg8::Epi<5> E{{HF, (float*)(HF + (size_t)M * FF), (float*)(HF + (size_t)M * FF) + (size_t)256 * 4 * FF, arg_in(20) + (size_t)L * 3 * FF, arg_in(21) + (size_t)L * FF, 0, FF, 44}};
            pg8::gemm_phase(lds, g, S, E);
        }
        SEAM(pb);
        if (IN(pb + 1)) convfix_phase(C, HF, (const float*)(HF + (size_t)M * FF), (const float*)(HF + (size_t)M * FF) + (size_t)256 * 4 * FF, arg_in(20) + (size_t)L * 3 * FF, arg_in(21) + (size_t)L * FF);
        SEAM(pb + 1);
        if (IN(pb + 2)) {
            pg8::Gemm g{HF, WDN, FF, FF, FF}; pg8::Order S; S.init(64, 8, 1, 0, C.G, (int)blockIdx.x);
            pg8::Epi<4> E{{RESB, STATS, nullptr, arg_in(23) + (size_t)L * D, arg_in(24) + (size_t)L * D, 0, D, 8}};
            pg8::gemm_phase(lds, g, S, E);
        }
        SEAM(pb + 2);
        if (IN(pb + 3)) {
            if (L == 0) {
                ln_phase(C, RESB, arg_in(25), arg_in(26), nullptr, (bf16_t*)(ws + O_X2B), STATS);
                transpose_mat(C, lds, arg_in(17), D, 3 * NQKV, (bf16_t*)(ws + O_WIN));
            } else {
                ln_phase(C, RESB, arg_in(25) + D, arg_in(26) + D, out, nullptr, nullptr);
            }
        }
        if (L == 0) SEAM(12);
    }
#undef IN
#undef SEAM
#undef ws
#undef out
}

extern "C" void kernel_launch(void* const* d_in, const int* in_sizes, int n_in, void* d_out, int out_size, void* d_ws, size_t ws_size, hipStream_t stream) {
    static int grid = 0;
    if (grid == 0) {
        if (n_in != 27 || out_size != M * D || ws_size < WS_NEED) { fprintf(stderr, "kernel_launch: unexpected shapes (n_in %d, out %d, ws %zu)\n", n_in, out_size, ws_size); grid = -1; return; }
        int dev = 0, cus = 0, per_cu = 0;
        hipGetDevice(&dev);
        hipDeviceGetAttribute(&cus, hipDeviceAttributeMultiprocessorCount, dev);
        if (hipFuncSetAttribute((const void*)mega, hipFuncAttributeMaxDynamicSharedMemorySize, LDS_BYTES) != hipSuccess) { fprintf(stderr, "kernel_launch: hipFuncSetAttribute failed\n"); grid = -1; return; }
        if (hipOccupancyMaxActiveBlocksPerMultiprocessor(&per_cu, (const void*)mega, 512, LDS_BYTES) != hipSuccess || per_cu < 1) per_cu = 1;
        (void)hipGetLastError();
        grid = cus * 1;
    }
    if (grid < 0) return;
    if (hipMemsetAsync((char*)d_ws + O_BAR, 0, XCD_BAR_WORDS * 4, stream) != hipSuccess) { fprintf(stderr, "kernel_launch: memset of barrier words failed\n"); return; }
    Args a{};
    for (int i = 0; i < 27; ++i) a.in[i] = (const float*)d_in[i];
    a.out = (float*)d_out; a.ws = (unsigned char*)d_ws; a.ph_lo = 0; a.ph_hi = 26;
    void* kargs[] = {&a};
    hipError_t e = hipLaunchCooperativeKernel((const void*)mega, dim3(grid), dim3(512), kargs, LDS_BYTES, stream);
    if (e != hipSuccess) fprintf(stderr, "kernel_launch: cooperative launch failed: %s (grid %d)\n", hipGetErrorString(e), grid);
}
```

```cpp
#include <hip/hip_runtime.h>
#include <hip/hip_cooperative_groups.h>
#include <cstdio>
#include <cstdint>
namespace cg = cooperative_groups;

#define LAS __attribute__((address_space(3)))
typedef unsigned short bf16_t;
typedef short bf16x8 __attribute__((ext_vector_type(8)));
typedef float f32x4 __attribute__((ext_vector_type(4)));
typedef float f32x2 __attribute__((ext_vector_type(2)));
typedef unsigned u32x4 __attribute__((ext_vector_type(4)));
typedef unsigned u32x2 __attribute__((ext_vector_type(2)));

constexpr int D = 2048, SEQ = 4096, NB = 4, M = NB * SEQ;
constexpr int FF = 5632, FF2 = 2 * FF;
constexpr int NQKV = 6144;
constexpr float LN_EPS = 1e-5f, GN_EPS = 64e-5f;
constexpr float ALPHA = 1.41421356237309515f;

constexpr size_t MiB = 1u << 20;
constexpr size_t O_BT1 = 1 * MiB, O_BT2 = 28 * MiB, O_WOR = 31 * MiB, O_WUP0 = 39 * MiB, O_WDN0 = 83 * MiB, O_H = 105 * MiB;
constexpr size_t O_XM = 129 * MiB, O_DEC = 129 * MiB, O_AA = 257 * MiB, O_RKV = 321 * MiB, O_G = 513 * MiB, O_BONUS = 577 * MiB, O_YG = 579 * MiB;
constexpr size_t O_RES = 513 * MiB;
constexpr size_t O_PRE = 129 * MiB, O_X1B = 129 * MiB, O_HF0 = 193 * MiB, O_PRE2 = 129 * MiB, O_X2B = 1 * MiB, O_WIN = 321 * MiB, O_WOA = 687 * MiB;
constexpr size_t O_QKV = 129 * MiB, O_OG = 401 * MiB, O_LSE = 593 * MiB, O_OM = 1 * MiB, O_PRE3 = 65 * MiB, O_X3B = 1 * MiB, O_WUP1 = 643 * MiB, O_WDN1 = 105 * MiB;
constexpr size_t O_HF1 = 259 * MiB, O_PRE4 = 65 * MiB;
constexpr size_t WS_NEED = 696 * MiB;
constexpr int LDS_BYTES = 147456;

typedef __bf16 bf16x2_t __attribute__((ext_vector_type(2)));
__device__ __forceinline__ unsigned cvt_pk_bf16(float lo, float hi) { const f32x2 v = {lo, hi}; return __builtin_bit_cast(unsigned, __builtin_convertvector(v, bf16x2_t)); }
__device__ __forceinline__ float bflo(unsigned w) { return __builtin_bit_cast(float, w << 16); }
__device__ __forceinline__ float bfhi(unsigned w) { return __builtin_bit_cast(float, w & 0xffff0000u); }
template <int CTRL> __device__ __forceinline__ float dppf(float v) { return __builtin_bit_cast(float, __builtin_amdgcn_update_dpp(0, __builtin_bit_cast(int, v), CTRL, 0xf, 0xf, false)); }
__device__ __forceinline__ float red16(float v) { v += dppf<0xB1>(v); v += dppf<0x4E>(v); v += dppf<0x141>(v); v += dppf<0x128>(v); return v; }
__device__ __forceinline__ float red8(float v) { v += dppf<0xB1>(v); v += dppf<0x4E>(v); v += dppf<0x141>(v); return v; }
__device__ __forceinline__ float wave_sum(float v) {
    v += dppf<0xB1>(v); v += dppf<0x4E>(v); v += dppf<0x141>(v); v += dppf<0x128>(v);
    v += __shfl_xor(v, 16); v += __shfl_xor(v, 32);
    return v;
}
__device__ __forceinline__ float sigmoidf_(float x) { return __builtin_amdgcn_rcpf(1.0f + __expf(-x)); }
__device__ __forceinline__ float tanh_fast(float x) { return 1.0f - 2.0f * __builtin_amdgcn_rcpf(1.0f + __expf(2.0f * x)); }

namespace pg8 {
constexpr int BM = 256, BK = 64, HALF = 128, HTB = HALF * BK * 2, STAGE_BYTES = 8 * HTB, NXCD = 8, WGM = 8;
__host__ __device__ __forceinline__ int lds_byte(int r, int c) { const int st = (r >> 4) * 2 + (c >> 5), rr = r & 15, cc = c & 31, ob = rr * 64 + cc * 2; return st * 1024 + (ob ^ (((ob >> 9) & 1) << 5)); }
__host__ __device__ __forceinline__ void stage_rc(int b, int& R, int& C) { const int st = b / 1024, sb = b % 1024, swz = sb ^ (((sb >> 9) & 1) << 5); R = (st >> 1) * 16 + swz / 64; C = (st & 1) * 32 + (swz % 64) / 2; }
__host__ __device__ __forceinline__ int perm32(int rho) { const int n = rho >> 4, i = rho & 15; return 8 * (i >> 2) + 4 * n + (i & 3); }

struct Unit { int pm, pn; };
struct Gemm { const bf16_t* A; const bf16_t* Bt; int K, lda, ldb; };

struct Order {
    int nM, nN, per, nsub, aoff, G, c;
    __device__ void init(int nM_, int nN_, int nsub_, int aoff_, int G_, int c_) { nM = nM_; nN = nN_; per = nM_ * nN_; nsub = nsub_; aoff = aoff_; G = G_; c = c_; }
    __device__ bool next(int i, Unit& u) const {
        const long L = (long)i * G + c; if (L >= (long)per * nsub) return false;
        const int sub = (int)(L / per); int wgid = (int)(L % per);
        { const int q = per / NXCD, r = per % NXCD, xcd = wgid % NXCD, off = wgid / NXCD; wgid = (xcd < r ? xcd * (q + 1) : r * (q + 1) + (xcd - r) * q) + off; }
        const int nig = WGM * nN, gid = wgid / nig, fm = gid * WGM, gsz = (nM - fm) < WGM ? (nM - fm) : WGM;
        u.pm = sub * aoff + fm + ((wgid % nig) % gsz); u.pn = sub * nN + (wgid % nig) / gsz; return true;
    }
};

template <class Epi>
__device__ __forceinline__ void gemm_phase(LAS unsigned char* lds, const Gemm g, const Order& S, const Epi& E) {
    int tid_ = threadIdx.x; asm volatile("" : "+v"(tid_));
    const int tid = tid_, wid = __builtin_amdgcn_readfirstlane(tid >> 6), lane = tid & 63, wr = wid >> 2, wc = wid & 3, fr = lane & 15, fq = lane >> 4;
    const int K = g.K, nt = K / BK;
    unsigned voffA[2], voffB[2];
#pragma unroll
    for (int i = 0; i < 2; ++i) { int R, C; stage_rc(tid * 16 + i * 8192, R, C); const int Rb = (R & ~31) + perm32(R & 31);
        voffA[i] = (unsigned)(R * g.lda + C) * 2u; voffB[i] = (unsigned)(Rb * g.ldb + C) * 2u; }
    const size_t kstep = (size_t)(BK * 2);
    const size_t hA = (size_t)HALF * g.lda * 2, hB = (size_t)HALF * g.ldb * 2;
    const size_t tA = 2 * hA, tB = 2 * hB;
    const unsigned ldsw = (unsigned)wid * 1024u;
    const int aoff = lds_byte(wr * 64 + fr, fq * 8), boff = lds_byte(wc * 32 + fr, fq * 8);
#define PG8_SA(b, h) (((b) * 2 + (h)) * HTB)
#define PG8_SB(b, h) ((4 + (b) * 2 + (h)) * HTB)
#define PG8_STAGE(bufoff, gbase, voff) do { _Pragma("unroll") for (int _i = 0; _i < 2; ++_i) \
        __builtin_amdgcn_global_load_lds((const unsigned*)((const char*)(gbase) + (voff)[_i]), (LAS unsigned*)(lds + (bufoff) + ldsw + _i * 8192), 16, 0, 0); } while (0)
#define PG8_LDA(dst, b, h) do { _Pragma("unroll") for (int m = 0; m < 4; ++m) _Pragma("unroll") for (int k = 0; k < 2; ++k) dst[m][k] = *(const LAS bf16x8*)(lds + PG8_SA(b, h) + aoff + m * 2048 + k * 1024); } while (0)
#define PG8_LDB(dst, b, h) do { _Pragma("unroll") for (int n = 0; n < 2; ++n) _Pragma("unroll") for (int k = 0; k < 2; ++k) dst[n][k] = *(const LAS bf16x8*)(lds + PG8_SB(b, h) + boff + n * 2048 + k * 1024); } while (0)
#define PG8_MMA(ai, bj, At, Bt) do { __builtin_amdgcn_s_setprio(1); _Pragma("unroll") for (int m = 0; m < 4; ++m) _Pragma("unroll") for (int n = 0; n < 2; ++n) _Pragma("unroll") for (int k = 0; k < 2; ++k) \
        acc[ai][bj][m][n] = __builtin_amdgcn_mfma_f32_16x16x32_bf16(Bt[n][k], At[m][k], acc[ai][bj][m][n], 0, 0, 0); __builtin_amdgcn_s_setprio(0); } while (0)
#define PG8_WAIT_V(n) asm volatile("s_waitcnt vmcnt(" #n ")" ::: "memory")
#define PG8_WAIT_L(n) asm volatile("s_waitcnt lgkmcnt(" #n ")" ::: "memory")
#define PG8_BAR __builtin_amdgcn_s_barrier()
#define PG8_SCHED __builtin_amdgcn_sched_barrier(0)
    Unit cur, nxt; int ui = 0;
    if (!S.next(0, cur)) return;
    f32x4 acc[2][2][4][2];
#pragma unroll
    for (int a = 0; a < 2; ++a)
#pragma unroll
        for (int b = 0; b < 2; ++b)
#pragma unroll
            for (int m = 0; m < 4; ++m)
#pragma unroll
                for (int n = 0; n < 2; ++n) acc[a][b][m][n] = (f32x4){0.f, 0.f, 0.f, 0.f};
    bf16x8 At[4][2], B0[2][2], B1[2][2];
    const char* cA = (const char*)g.A + (size_t)cur.pm * tA; const char* cB = (const char*)g.Bt + (size_t)cur.pn * tB;
    PG8_STAGE(PG8_SB(0, 0), cB, voffB); PG8_STAGE(PG8_SA(0, 0), cA, voffA); PG8_STAGE(PG8_SB(0, 1), cB + hB, voffB); PG8_STAGE(PG8_SA(0, 1), cA + hA, voffA);
    if (wr == 1) PG8_BAR;
    PG8_WAIT_V(4); PG8_BAR;
    PG8_STAGE(PG8_SB(1, 0), cB + kstep, voffB); PG8_STAGE(PG8_SA(1, 0), cA + kstep, voffA); PG8_STAGE(PG8_SB(1, 1), cB + hB + kstep, voffB);
    PG8_WAIT_V(6); PG8_BAR;
    for (;;) {
        const bool has_next = S.next(ui + 1, nxt);
        const char* nA = has_next ? (const char*)g.A + (size_t)nxt.pm * tA : cA; const char* nB = has_next ? (const char*)g.Bt + (size_t)nxt.pn * tB : cB;
        for (int t = 0; t < nt; t += 2) {
            const bool last = (t == nt - 2);
            const char* a1 = cA + (size_t)(t + 1) * kstep;
            const char* a2 = last ? nA : cA + (size_t)(t + 2) * kstep; const char* b2 = last ? nB : cB + (size_t)(t + 2) * kstep;
            const char* a3 = a2 + kstep; const char* b3 = b2 + kstep;
            PG8_LDB(B0, 0, 0); PG8_SCHED; PG8_LDA(At, 0, 0); PG8_STAGE(PG8_SA(1, 1), a1 + hA, voffA);
            PG8_WAIT_L(8); PG8_BAR; PG8_WAIT_L(0); PG8_MMA(0, 0, At, B0); PG8_BAR; PG8_SCHED;
            PG8_LDB(B1, 0, 1); PG8_STAGE(PG8_SB(0, 0), b2, voffB);
            PG8_BAR; PG8_WAIT_L(0); PG8_MMA(0, 1, At, B1); PG8_BAR;
            PG8_LDA(At, 0, 1); PG8_STAGE(PG8_SA(0, 0), a2, voffA);
            PG8_BAR; PG8_WAIT_L(0); PG8_MMA(1, 0, At, B0); PG8_BAR; PG8_SCHED;
            PG8_STAGE(PG8_SB(0, 1), b2 + hB, voffB);
            PG8_WAIT_V(6); PG8_BAR; PG8_MMA(1, 1, At, B1); PG8_BAR;
            PG8_LDB(B0, 1, 0); PG8_SCHED; PG8_LDA(At, 1, 0); PG8_STAGE(PG8_SA(0, 1), a2 + hA, voffA);
            PG8_WAIT_L(8); PG8_BAR; PG8_WAIT_L(0); PG8_MMA(0, 0, At, B0); PG8_BAR; PG8_SCHED;
            PG8_LDB(B1, 1, 1); PG8_STAGE(PG8_SB(1, 0), b3, voffB);
            PG8_BAR; PG8_WAIT_L(0); PG8_MMA(0, 1, At, B1); PG8_BAR;
            PG8_LDA(At, 1, 1); PG8_STAGE(PG8_SA(1, 0), a3, voffA);
            PG8_BAR; PG8_WAIT_L(0); PG8_MMA(1, 0, At, B0); PG8_BAR; PG8_SCHED;
            PG8_STAGE(PG8_SB(1, 1), b3 + hB, voffB);
            PG8_WAIT_V(6); PG8_BAR; PG8_MMA(1, 1, At, B1); PG8_BAR;
        }
        E(acc, cur, wr, wc, fr, fq);
        if (!has_next) break;
#pragma unroll
        for (int a = 0; a < 2; ++a)
#pragma unroll
            for (int b = 0; b < 2; ++b)
#pragma unroll
                for (int m = 0; m < 4; ++m)
#pragma unroll
                    for (int n = 0; n < 2; ++n) acc[a][b][m][n] = (f32x4){0.f, 0.f, 0.f, 0.f};
        cur = nxt; cA = nA; cB = nB; ++ui;
    }
    PG8_WAIT_V(0);
    if (wr == 0) PG8_BAR;
    PG8_BAR;
#undef PG8_SA
#undef PG8_SB
#undef PG8_STAGE
#undef PG8_LDA
#undef PG8_LDB
#undef PG8_MMA
#undef PG8_WAIT_V
#undef PG8_WAIT_L
#undef PG8_BAR
#undef PG8_SCHED
}

struct EpiArgs { void* o0; void* o1; void* o2; const float* p0; const float* p1; size_t sstride; int ldc; int nN; };
template <int MODE> struct Epi {
    EpiArgs a;
    __device__ __forceinline__ void operator()(const f32x4 (&acc)[2][2][4][2], const Unit& u, int wr, int wc, int fr, int fq) const {
        const int sub = u.pn / a.nN;
        const int row0 = (u.pm & 63) * BM + wr * 64 + fr, col0 = (u.pn - sub * a.nN) * BM + wc * 32 + 8 * fq;
        if constexpr (MODE == 0 || MODE == 1) {
            bf16_t* base = (bf16_t*)a.o0 + (size_t)sub * a.sstride;
#pragma unroll
            for (int ai = 0; ai < 2; ++ai)
#pragma unroll
                for (int m = 0; m < 4; ++m) { bf16_t* rowp = base + (size_t)(row0 + ai * HALF + m * 16) * a.ldc + col0;
#pragma unroll
                    for (int bj = 0; bj < 2; ++bj) { f32x4 v0 = acc[ai][bj][m][0], v1 = acc[ai][bj][m][1];
                        if constexpr (MODE == 1) {
                            if (sub == 0) {
#pragma unroll
                                for (int j = 0; j < 4; ++j) { v0[j] = tanh_fast(v0[j]); v1[j] = tanh_fast(v1[j]); } }
                            else if (sub == 2) {
#pragma unroll
                                for (int j = 0; j < 4; ++j) { v0[j] = sigmoidf_(v0[j]); v1[j] = sigmoidf_(v1[j]); } }
                        }
                        u32x4 w; w.x = cvt_pk_bf16(v0[0], v0[1]); w.y = cvt_pk_bf16(v0[2], v0[3]); w.z = cvt_pk_bf16(v1[0], v1[1]); w.w = cvt_pk_bf16(v1[2], v1[3]);
                        *(u32x4*)(rowp + bj * HALF) = w; } }
        } else if constexpr (MODE == 2) {
            if (sub == 0) {
#pragma unroll
                for (int bj = 0; bj < 2; ++bj) {
                    const int c = col0 + bj * HALF;
                    const f32x4 p0v = *(const f32x4*)(a.p0 + c), p1v = *(const f32x4*)(a.p0 + c + 4);
#pragma unroll
                    for (int ai = 0; ai < 2; ++ai)
#pragma unroll
                        for (int m = 0; m < 4; ++m) { bf16_t* dst = (bf16_t*)a.o0 + (size_t)(row0 + ai * HALF + m * 16) * D + c;
                            f32x4 v0 = acc[ai][bj][m][0] + p0v, v1 = acc[ai][bj][m][1] + p1v;
#pragma unroll
                            for (int j = 0; j < 4; ++j) {
                                v0[j] = -0.6065306597126334f * __builtin_amdgcn_rcpf(1.0f + __expf(-v0[j]));
                                v1[j] = -0.6065306597126334f * __builtin_amdgcn_rcpf(1.0f + __expf(-v1[j])); }
                            u32x4 w8; w8.x = cvt_pk_bf16(v0[0], v0[1]); w8.y = cvt_pk_bf16(v0[2], v0[3]); w8.z = cvt_pk_bf16(v1[0], v1[1]); w8.w = cvt_pk_bf16(v1[2], v1[3]);
                            *(u32x4*)dst = w8; asm volatile("" ::: "memory"); }
                }
            } else if (sub == 1) {
#pragma unroll
                for (int bj = 0; bj < 2; ++bj) {
                    const int c = col0 + bj * HALF;
                    const f32x4 p0v = *(const f32x4*)(a.p1 + c), p1v = *(const f32x4*)(a.p1 + c + 4);
#pragma unroll
                    for (int ai = 0; ai < 2; ++ai)
#pragma unroll
                        for (int m = 0; m < 4; ++m) { bf16_t* dst = (bf16_t*)a.o1 + (size_t)(row0 + ai * HALF + m * 16) * D + c;
                            f32x4 v0 = acc[ai][bj][m][0] + p0v, v1 = acc[ai][bj][m][1] + p1v;
#pragma unroll
                            for (int j = 0; j < 4; ++j) { v0[j] = sigmoidf_(v0[j]); v1[j] = sigmoidf_(v1[j]); }
                            u32x4 w; w.x = cvt_pk_bf16(v0[0], v0[1]); w.y = cvt_pk_bf16(v0[2], v0[3]); w.z = cvt_pk_bf16(v1[0], v1[1]); w.w = cvt_pk_bf16(v1[2], v1[3]);
                            *(u32x4*)dst = w; asm volatile("" ::: "memory"); }
                }
            } else {
#pragma unroll
                for (int ai = 0; ai < 2; ++ai)
#pragma unroll
                    for (int m = 0; m < 4; ++m) { bf16_t* rowp = (bf16_t*)a.o2 + (size_t)(row0 + ai * HALF + m * 16) * D + col0;
#pragma unroll
                        for (int bj = 0; bj < 2; ++bj) { const f32x4 v0 = acc[ai][bj][m][0], v1 = acc[ai][bj][m][1];
                            u32x4 w; w.x = cvt_pk_bf16(v0[0], v0[1]); w.y = cvt_pk_bf16(v0[2], v0[3]); w.z = cvt_pk_bf16(v1[0], v1[1]); w.w = cvt_pk_bf16(v1[2], v1[3]);
                            *(u32x4*)(rowp + bj * HALF) = w; } }
            }
        } else if constexpr (MODE == 5) {
            bf16_t* ACT = (bf16_t*)a.o0; float* GS = (float*)a.o1; float* US = (float*)a.o2;
            const int chan0 = u.pn * HALF + wc * 32 + 8 * fq;
#pragma unroll
            for (int n = 0; n < 2; ++n) {
                const int c = chan0 + 4 * n;
                const f32x4 w0 = *(const f32x4*)(a.p0 + c), w1 = *(const f32x4*)(a.p0 + FF + c), w2 = *(const f32x4*)(a.p0 + 2 * FF + c), cb = *(const f32x4*)(a.p1 + c);
#pragma unroll
                for (int ai = 0; ai < 2; ++ai)
#pragma unroll
                    for (int m = 0; m < 4; ++m) {
                        const f32x4 g0 = acc[ai][0][m][n], up = acc[ai][1][m][n];
                        f32x4 g1, g2;
#pragma unroll
                        for (int j = 0; j < 4; ++j) {
                            const int ln = (int)(threadIdx.x & 63);
                            const float cur = g0[j];
                            const float prev = (m > 0) ? acc[ai][0][m > 0 ? m - 1 : 0][n][j] : 0.f;
                            const float t1c = __builtin_bit_cast(float, __builtin_amdgcn_update_dpp(0, __builtin_bit_cast(int, cur), 0x111, 0xf, 0xf, true)), t1p = __shfl(prev, (ln + 15) & 63);
                            const float t2c = __builtin_bit_cast(float, __builtin_amdgcn_update_dpp(0, __builtin_bit_cast(int, cur), 0x112, 0xf, 0xf, true)), t2p = __shfl(prev, (ln + 14) & 63);
                            g1[j] = (fr >= 1) ? t1c : t1p;
                            g2[j] = (fr >= 2) ? t2c : t2p;
                        }
                        const f32x4 av = cb + w0 * g2 + w1 * g1 + w2 * g0;
                        f32x4 o;
#pragma unroll
                        for (int j = 0; j < 4; ++j) o[j] = av[j] * __builtin_amdgcn_rcpf(1.0f + __expf(-av[j])) * up[j];
                        const int row = row0 + ai * HALF + m * 16;
                        if (!(m == 0 && fr < 2)) { u32x2 w; w.x = cvt_pk_bf16(o[0], o[1]); w.y = cvt_pk_bf16(o[2], o[3]); *(u32x2*)(ACT + (size_t)row * FF + c) = w; }
                        if (m == 0 && fr < 2) { const int grp = row >> 6; *(f32x4*)(GS + ((size_t)grp * 4 + fr) * FF + c) = g0; *(f32x4*)(US + ((size_t)grp * 2 + fr) * FF + c) = up; }
                        if (m == 3 && fr >= 14) { const int grp = row >> 6; *(f32x4*)(GS + ((size_t)grp * 4 + 2 + (fr - 14)) * FF + c) = g0; }
                    }
            }
        } else if constexpr (MODE == 4) {
            bf16_t* RES = (bf16_t*)a.o0; const float* st = (const float*)a.o1;
#pragma unroll
            for (int bj = 0; bj < 2; ++bj) {
                const int c = col0 + bj * HALF;
                const f32x4 g0 = *(const f32x4*)(a.p0 + c), g1 = *(const f32x4*)(a.p0 + c + 4), b0 = *(const f32x4*)(a.p1 + c), b1 = *(const f32x4*)(a.p1 + c + 4);
#pragma unroll
                for (int ai = 0; ai < 2; ++ai)
#pragma unroll
                    for (int m = 0; m < 4; ++m) { const int row = row0 + ai * HALF + m * 16; const f32x2 ms = *(const f32x2*)(st + 2 * (size_t)row);
                        bf16_t* p = RES + (size_t)row * D + c;
                        const u32x4 rw8 = *(const u32x4*)p;
                        const f32x4 r0 = (f32x4){bflo(rw8.x), bfhi(rw8.x), bflo(rw8.y), bfhi(rw8.y)}, r1 = (f32x4){bflo(rw8.z), bfhi(rw8.z), bflo(rw8.w), bfhi(rw8.w)};
                        const f32x4 o0 = ((r0 - ms.x) * ms.y * g0 + b0) * ALPHA + acc[ai][bj][m][0], o1 = ((r1 - ms.x) * ms.y * g1 + b1) * ALPHA + acc[ai][bj][m][1];
                        u32x4 w8; w8.x = cvt_pk_bf16(o0[0], o0[1]); w8.y = cvt_pk_bf16(o0[2], o0[3]); w8.z = cvt_pk_bf16(o1[0], o1[1]); w8.w = cvt_pk_bf16(o1[2], o1[3]);
                        *(u32x4*)p = w8; }
                asm volatile("" ::: "memory");
            }
        } else {
#pragma unroll
            for (int ai = 0; ai < 2; ++ai)
#pragma unroll
                for (int m = 0; m < 4; ++m) { const size_t off = (size_t)(row0 + ai * HALF + m * 16) * a.ldc + col0;
#pragma unroll
                    for (int bj = 0; bj < 2; ++bj) {
                        const f32x4 r0 = *(const f32x4*)(a.p0 + off + bj * HALF), r1 = *(const f32x4*)(a.p0 + off + bj * HALF + 4);
                        const f32x4 o0 = r0 * ALPHA + acc[ai][bj][m][0], o1 = r1 * ALPHA + acc[ai][bj][m][1];
                        u32x4 w8; w8.x = cvt_pk_bf16(o0[0], o0[1]); w8.y = cvt_pk_bf16(o0[2], o0[3]); w8.z = cvt_pk_bf16(o1[0], o1[1]); w8.w = cvt_pk_bf16(o1[2], o1[3]);
                        *(u32x4*)((bf16_t*)a.o0 + off + bj * HALF) = w8; }
                    asm volatile("" ::: "memory"); }
        }
    }
};
}

struct Args {
    const float* in[27];
    float* out;
    unsigned char* ws;
    int ph_lo, ph_hi;
};

struct Ctx { int tid, lane, wave, G, gw, NGW; };
__device__ __forceinline__ const float* arg_in(int k) {
    typedef const char __attribute__((address_space(4)))* kptr_t;
    kptr_t kp = (kptr_t)__builtin_amdgcn_kernarg_segment_ptr();
    asm volatile("" : "+s"(kp));
    return *(const float* const __attribute__((address_space(4)))*)(kp + 8 * k);
}
__device__ __forceinline__ float* arg_out() { return (float*)arg_in(27); }
__device__ __forceinline__ unsigned char* arg_ws() { return (unsigned char*)arg_in(28); }
__device__ __forceinline__ int arg_int(int byteoff) {
    typedef const char __attribute__((address_space(4)))* kptr_t;
    kptr_t kp = (kptr_t)__builtin_amdgcn_kernarg_segment_ptr();
    asm volatile("" : "+s"(kp));
    return *(const int __attribute__((address_space(4)))*)(kp + byteoff);
}
__device__ __forceinline__ int opaque_tid() { int t = threadIdx.x; asm volatile("" : "+v"(t)); return t; }
__device__ __forceinline__ Ctx mkctx() { Ctx C; C.tid = opaque_tid(); C.lane = C.tid & 63; C.wave = __builtin_amdgcn_readfirstlane(C.tid >> 6); C.G = gridDim.x;
    int b = blockIdx.x; asm volatile("" : "+s"(b)); C.gw = b * 8 + C.wave; C.NGW = C.G * 8; return C; }

__device__ __forceinline__ void transpose_item(const float* W, int K, int N, bf16_t* WT, LAS float* scr, int item, int lane) {
    const int nblk = N / 32, kb = item / nblk, nb = item % nblk, k0 = 64 * kb, n0 = 32 * nb;
#pragma unroll 8
    for (int i = 0; i < 32; ++i) { const int kk = 2 * i + (lane >> 5); scr[kk * 33 + (lane & 31)] = W[(size_t)(k0 + kk) * N + n0 + (lane & 31)]; }
    asm volatile("s_waitcnt lgkmcnt(0)" ::: "memory");
    const int c = lane & 7;
#pragma unroll
    for (int j = 0; j < 4; ++j) { const int n = (lane >> 3) + 8 * j; const LAS float* s = scr + (8 * c) * 33 + n;
        u32x4 o; o.x = cvt_pk_bf16(s[0 * 33], s[1 * 33]); o.y = cvt_pk_bf16(s[2 * 33], s[3 * 33]); o.z = cvt_pk_bf16(s[4 * 33], s[5 * 33]); o.w = cvt_pk_bf16(s[6 * 33], s[7 * 33]);
        *(u32x4*)(WT + (size_t)(n0 + n) * K + k0 + 8 * c) = o; }
    asm volatile("s_waitcnt lgkmcnt(0)" ::: "memory");
}
__device__ __forceinline__ void titem_issue(const float* W, int N, int item, int lane, float (&v)[32]) {
    const int nblk = N / 32, kb = item / nblk, nb = item % nblk, k0 = 64 * kb, n0 = 32 * nb;
#pragma unroll
    for (int i = 0; i < 32; ++i) { const int kk = 2 * i + (lane >> 5); v[i] = W[(size_t)(k0 + kk) * N + n0 + (lane & 31)]; }
}
__device__ __forceinline__ void titem_finish(int K, int N, bf16_t* WT, LAS float* scr, int item, int lane, int ffremap, const float (&v)[32]) {
    const int nblk = N / 32, kb = item / nblk, nb = item % nblk, k0 = 64 * kb, n0 = 32 * nb;
    int n0d = n0; if (ffremap) { const int hh = n0 / FF, cc = n0 - hh * FF; n0d = (cc >> 7) * 256 + hh * 128 + (cc & 127); }
#pragma unroll
    for (int i = 0; i < 32; ++i) { const int kk = 2 * i + (lane >> 5); scr[kk * 33 + (lane & 31)] = v[i]; }
    asm volatile("s_waitcnt lgkmcnt(0)" ::: "memory");
    const int c = lane & 7;
#pragma unroll
    for (int j = 0; j < 4; ++j) { const int n = (lane >> 3) + 8 * j; const LAS float* sp = scr + (8 * c) * 33 + n;
        u32x4 o; o.x = cvt_pk_bf16(sp[0 * 33], sp[1 * 33]); o.y = cvt_pk_bf16(sp[2 * 33], sp[3 * 33]); o.z = cvt_pk_bf16(sp[4 * 33], sp[5 * 33]); o.w = cvt_pk_bf16(sp[6 * 33], sp[7 * 33]);
        *(u32x4*)(WT + (size_t)(n0d + n) * K + k0 + 8 * c) = o; }
    asm volatile("s_waitcnt lgkmcnt(0)" ::: "memory");
}
__device__ __forceinline__ void transpose_item64(const float* W, int K, int N, bf16_t* WT, LAS float* scr, int item, int lane, int ffremap) {
    const int nblk = N / 64, kb = item / nblk, nb = item % nblk, k0 = 64 * kb, n0 = 64 * nb;
    int n0d = n0; if (ffremap) { const int hh = n0 / FF, cc = n0 - hh * FF; n0d = (cc >> 7) * 256 + hh * 128 + (cc & 127); }
    const int c4 = 4 * (lane & 15), kq = lane >> 4;
#pragma unroll 4
    for (int i = 0; i < 16; ++i) { const int kk = 4 * i + kq; const f32x4 v = *(const f32x4*)(W + (size_t)(k0 + kk) * N + n0 + c4);
        LAS float* d = scr + kk * 65 + c4; d[0] = v[0]; d[1] = v[1]; d[2] = v[2]; d[3] = v[3]; }
    asm volatile("s_waitcnt lgkmcnt(0)" ::: "memory");
    const int c = lane & 7;
#pragma unroll
    for (int j = 0; j < 8; ++j) { const int n = (lane >> 3) + 8 * j; const LAS float* sp = scr + (8 * c) * 65 + n;
        u32x4 o; o.x = cvt_pk_bf16(sp[0 * 65], sp[1 * 65]); o.y = cvt_pk_bf16(sp[2 * 65], sp[3 * 65]); o.z = cvt_pk_bf16(sp[4 * 65], sp[5 * 65]); o.w = cvt_pk_bf16(sp[6 * 65], sp[7 * 65]);
        *(u32x4*)(WT + (size_t)(n0d + n) * K + k0 + 8 * c) = o; }
    asm volatile("s_waitcnt lgkmcnt(0)" ::: "memory");
}
__device__ __forceinline__ void transpose_mat(const Ctx& C_unused, LAS unsigned char* lds, const float* W, int K, int N, bf16_t* WT, int ffremap = 0) {
    const Ctx C = mkctx();
    LAS float* scr = (LAS float*)(lds + C.wave * 16640);
    if (N % 64 == 0) {
        const int items = (K / 64) * (N / 64);
        for (int it = C.gw; it < items; it += C.NGW) transpose_item64(W, K, N, WT, scr, it, C.lane, ffremap);
    } else {
        const int items = (K / 64) * (N / 32);
        for (int it = C.gw; it < items; it += C.NGW) transpose_item(W, K, N, WT, scr, it, C.lane);
    }
}
__device__ __forceinline__ void transpose_pad96(const Ctx& C_unused, const float* W, bf16_t* WT) {
    const Ctx C = mkctx();
    const int gt = C.gw * 64 + C.lane, NT = C.NGW * 64;
    for (int idx = gt; idx < 2048 * 32; idx += NT) { const int n = idx & 2047, k8 = idx >> 11; u32x4 o = (u32x4){0u, 0u, 0u, 0u};
        if (k8 < 12) { float v[8];
#pragma unroll
            for (int j = 0; j < 8; ++j) v[j] = W[(size_t)(8 * k8 + j) * 2048 + n];
            o.x = cvt_pk_bf16(v[0], v[1]); o.y = cvt_pk_bf16(v[2], v[3]); o.z = cvt_pk_bf16(v[4], v[5]); o.w = cvt_pk_bf16(v[6], v[7]); }
        *(u32x4*)(WT + (size_t)n * 256 + 8 * k8) = o; }
}
__device__ __forceinline__ void zero_fill16(const Ctx& C_unused, void* p, size_t n16) {
    const Ctx C = mkctx();
    const size_t gt = (size_t)C.gw * 64 + C.lane, NT = (size_t)C.NGW * 64;
    for (size_t i = gt; i < n16; i += NT) ((u32x4*)p)[i] = (u32x4){0u, 0u, 0u, 0u};
}
__device__ __forceinline__ void mix_phase(const Ctx& C_unused, const float* x, const float* mu, int s0, int s1, int s2, bf16_t* XM) {
    const Ctx C = mkctx();
    const int gt = C.gw * 64 + C.lane, NT = C.NGW * 64;
    for (int idx = gt; idx < M * (D / 4); idx += NT) {
        const int t = idx >> 9, c4 = idx & 511;
        const f32x4 xv = ((const f32x4*)x)[idx];
        f32x4 xp = (f32x4){0.f, 0.f, 0.f, 0.f};
        if (t & (SEQ - 1)) xp = ((const f32x4*)x)[idx - 512];
        const f32x4 xx = xp - xv;
        const f32x4 m0 = ((const f32x4*)(mu + s0 * D))[c4], m1 = ((const f32x4*)(mu + s1 * D))[c4], m2 = ((const f32x4*)(mu + s2 * D))[c4];
        const f32x4 a = xv + xx * m0, b = xv + xx * m1, c = xv + xx * m2;
        u32x2 w;
        w.x = cvt_pk_bf16(a[0], a[1]); w.y = cvt_pk_bf16(a[2], a[3]); ((u32x2*)XM)[idx] = w;
        w.x = cvt_pk_bf16(b[0], b[1]); w.y = cvt_pk_bf16(b[2], b[3]); ((u32x2*)(XM + (size_t)M * D))[idx] = w;
        w.x = cvt_pk_bf16(c[0], c[1]); w.y = cvt_pk_bf16(c[2], c[3]); ((u32x2*)(XM + (size_t)2 * M * D))[idx] = w;
    }
}
__device__ __forceinline__ void ln_phase(const Ctx& C_unused, const bf16_t* src, const float* g, const float* b, float* of32, bf16_t* obf, float* stats) {
    const Ctx C = mkctx();
    u32x4 nx[4];
    if (C.gw < M) { const u32x4* xr = (const u32x4*)(src + (size_t)C.gw * D) + C.lane;
#pragma unroll
        for (int j = 0; j < 4; ++j) nx[j] = xr[64 * j]; }
    for (int m = C.gw; m < M; m += C.NGW) {
        f32x4 v[8]; float s = 0.f;
#pragma unroll
        for (int j = 0; j < 4; ++j) { v[2 * j] = (f32x4){bflo(nx[j].x), bfhi(nx[j].x), bflo(nx[j].y), bfhi(nx[j].y)}; v[2 * j + 1] = (f32x4){bflo(nx[j].z), bfhi(nx[j].z), bflo(nx[j].w), bfhi(nx[j].w)}; }
#pragma unroll
        for (int j = 0; j < 8; ++j) s += (v[j][0] + v[j][1]) + (v[j][2] + v[j][3]);
        if (m + C.NGW < M) { const u32x4* xr = (const u32x4*)(src + (size_t)(m + C.NGW) * D) + C.lane;
#pragma unroll
            for (int j = 0; j < 4; ++j) nx[j] = xr[64 * j]; }
        const float mean = wave_sum(s) * (1.f / D); float s2 = 0.f;
#pragma unroll
        for (int j = 0; j < 8; ++j) { v[j] = v[j] - mean; s2 += (v[j][0] * v[j][0] + v[j][1] * v[j][1]) + (v[j][2] * v[j][2] + v[j][3] * v[j][3]); }
        const float rstd = 1.0f / sqrtf(wave_sum(s2) * (1.f / D) + LN_EPS);
        if (stats && C.lane == 0) *(f32x2*)(stats + 2 * (size_t)m) = (f32x2){mean, rstd};
#pragma unroll
        for (int j = 0; j < 4; ++j) {
            const int ch = C.lane + 64 * j;
            const f32x4 ga = ((const f32x4*)g)[2 * ch], gb_ = ((const f32x4*)g)[2 * ch + 1], ba = ((const f32x4*)b)[2 * ch], bb = ((const f32x4*)b)[2 * ch + 1];
            const f32x4 o0 = v[2 * j] * rstd * ga + ba, o1 = v[2 * j + 1] * rstd * gb_ + bb;
            if (of32) { ((f32x4*)(of32 + (size_t)m * D))[2 * ch] = o0; ((f32x4*)(of32 + (size_t)m * D))[2 * ch + 1] = o1; }
            if (obf) { u32x4 w; w.x = cvt_pk_bf16(o0[0], o0[1]); w.y = cvt_pk_bf16(o0[2], o0[3]); w.z = cvt_pk_bf16(o1[0], o1[1]); w.w = cvt_pk_bf16(o1[2], o1[3]); ((u32x4*)(obf + (size_t)m * D))[ch] = w; }
        }
    }
}
__device__ __forceinline__ void convact_phase(const Ctx& C_unused, bf16_t* HF, const float* cw, const float* cb) {
    const Ctx C = mkctx();
    constexpr int TT = 32, NCB = FF / 512;
    const int nitems = (M / TT) * NCB;
    for (int it = C.gw; it < nitems; it += C.NGW) {
        const int cbk = it % NCB, tt = it / NCB, t0 = tt * TT, c0 = cbk * 512 + C.lane * 8;
        float w0[8], w1[8], w2[8], bs[8], g2[8], g1[8];
#pragma unroll
        for (int j = 0; j < 8; ++j) { w0[j] = cw[c0 + j]; w1[j] = cw[FF + c0 + j]; w2[j] = cw[2 * FF + c0 + j]; bs[j] = cb[c0 + j]; g2[j] = 0.f; g1[j] = 0.f; }
        if (t0 & (SEQ - 1)) {
            const u32x4 a = *(const u32x4*)(HF + (size_t)(t0 - 2) * FF2 + c0), b = *(const u32x4*)(HF + (size_t)(t0 - 1) * FF2 + c0);
            g2[0] = bflo(a.x); g2[1] = bfhi(a.x); g2[2] = bflo(a.y); g2[3] = bfhi(a.y); g2[4] = bflo(a.z); g2[5] = bfhi(a.z); g2[6] = bflo(a.w); g2[7] = bfhi(a.w);
            g1[0] = bflo(b.x); g1[1] = bfhi(b.x); g1[2] = bflo(b.y); g1[3] = bfhi(b.y); g1[4] = bflo(b.z); g1[5] = bfhi(b.z); g1[6] = bflo(b.w); g1[7] = bfhi(b.w);
        }
#pragma unroll 4
        for (int t = t0; t < t0 + TT; ++t) {
            const u32x4 gv = *(const u32x4*)(HF + (size_t)t * FF2 + c0), uv = *(const u32x4*)(HF + (size_t)t * FF2 + FF + c0);
            float g0[8], up[8], o[8];
            g0[0] = bflo(gv.x); g0[1] = bfhi(gv.x); g0[2] = bflo(gv.y); g0[3] = bfhi(gv.y); g0[4] = bflo(gv.z); g0[5] = bfhi(gv.z); g0[6] = bflo(gv.w); g0[7] = bfhi(gv.w);
            up[0] = bflo(uv.x); up[1] = bfhi(uv.x); up[2] = bflo(uv.y); up[3] = bfhi(uv.y); up[4] = bflo(uv.z); up[5] = bfhi(uv.z); up[6] = bflo(uv.w); up[7] = bfhi(uv.w);
#pragma unroll
            for (int j = 0; j < 8; ++j) { const float a = bs[j] + g2[j] * w0[j] + g1[j] * w1[j] + g0[j] * w2[j]; o[j] = a * sigmoidf_(a) * up[j]; g2[j] = g1[j]; g1[j] = g0[j]; }
            u32x4 w; w.x = cvt_pk_bf16(o[0], o[1]); w.y = cvt_pk_bf16(o[2], o[3]); w.z = cvt_pk_bf16(o[4], o[5]); w.w = cvt_pk_bf16(o[6], o[7]);
            *(u32x4*)(HF + (size_t)t * FF2 + FF + c0) = w;
        }
    }
}

__device__ __forceinline__ void convfix_phase(const Ctx& C_unused, bf16_t* ACT, const float* GS, const float* US, const float* cw, const float* cb) {
    const Ctx C = mkctx();
    const int gt = C.gw * 64 + C.lane, NT = C.NGW * 64;
    constexpr int C4 = FF / 4;
    for (int idx = gt; idx < 256 * 2 * C4; idx += NT) {
        const int c = 4 * (idx % C4), rr = (idx / C4) & 1, g = idx / (2 * C4);
        const bool first = (g & 63) == 0;
        const f32x4 z = (f32x4){0.f, 0.f, 0.f, 0.f};
        const f32x4 g0 = *(const f32x4*)(GS + ((size_t)g * 4 + rr) * FF + c);
        f32x4 g1, g2;
        if (rr == 0) { g1 = first ? z : *(const f32x4*)(GS + ((size_t)(g - 1) * 4 + 3) * FF + c); g2 = first ? z : *(const f32x4*)(GS + ((size_t)(g - 1) * 4 + 2) * FF + c); }
        else { g1 = *(const f32x4*)(GS + ((size_t)g * 4 + 0) * FF + c); g2 = first ? z : *(const f32x4*)(GS + ((size_t)(g - 1) * 4 + 3) * FF + c); }
        const f32x4 up = *(const f32x4*)(US + ((size_t)g * 2 + rr) * FF + c);
        const f32x4 w0 = *(const f32x4*)(cw + c), w1 = *(const f32x4*)(cw + FF + c), w2 = *(const f32x4*)(cw + 2 * FF + c), bs = *(const f32x4*)(cb + c);
        const f32x4 av = bs + w0 * g2 + w1 * g1 + w2 * g0;
        f32x4 o;
#pragma unroll
        for (int j = 0; j < 4; ++j) o[j] = av[j] * sigmoidf_(av[j]) * up[j];
        u32x2 w; w.x = cvt_pk_bf16(o[0], o[1]); w.y = cvt_pk_bf16(o[2], o[3]);
        *(u32x2*)(ACT + ((size_t)g * 64 + rr) * FF + c) = w;
    }
}

constexpr int TC = 32, SROW = 360;
struct ScanP { const bf16_t* R; const bf16_t* K; const bf16_t* V; const bf16_t* AA; const bf16_t* DEC; const float* k_k; const float* k_a; const float* r_k; bf16_t* Y; float* BONUS;
               const float* t_up; const float* t_dn; const float* t_wo; bf16_t* d_up; bf16_t* d_dn; bf16_t* d_wo;
               const float* t_up0; const float* t_dn0; const float* t_wo0; bf16_t* d_up0; bf16_t* d_dn0; bf16_t* d_wo0; };
constexpr int TW_I0 = (D / 64) * (FF2 / 32), TW_I1 = (FF / 64) * (D / 32), TW_I2 = (D / 64) * (D / 32), TW_HALF = TW_I0 + TW_I1 + TW_I2, TW_TOTAL = 2 * TW_HALF;
#define TW_DECODE(P, ti, SRC, DST, KK, NN, IT, RM) const bool l1_ = (ti) >= TW_HALF; const int t_ = l1_ ? (ti) - TW_HALF : (ti); \
    const int sg_ = (t_ < TW_I0) ? 0 : ((t_ < TW_I0 + TW_I1) ? 1 : 2); \
    const float* SRC = sg_ == 0 ? (l1_ ? (P).t_up : (P).t_up0) : (sg_ == 1 ? (l1_ ? (P).t_dn : (P).t_dn0) : (l1_ ? (P).t_wo : (P).t_wo0)); \
    bf16_t* DST = sg_ == 0 ? (l1_ ? (P).d_up : (P).d_up0) : (sg_ == 1 ? (l1_ ? (P).d_dn : (P).d_dn0) : (l1_ ? (P).d_wo : (P).d_wo0)); \
    const int KK = sg_ == 1 ? FF : D, NN = sg_ == 0 ? FF2 : D, IT = sg_ == 0 ? t_ : (sg_ == 1 ? t_ - TW_I0 : t_ - TW_I0 - TW_I1), RM = sg_ == 0 ? 1 : 0;
#define SCAN_LOADRAW(RR, KR, AR, DR, VR, tok_) do { const size_t t__ = (tok_); \
    RR = *(const u32x2*)(P.R + t__ * D + col); KR = *(const u32x2*)(P.K + t__ * D + col); AR = *(const u32x2*)(P.AA + t__ * D + col); \
    DR = *(const u32x2*)(P.DEC + t__ * D + col); VR = *(const unsigned*)(P.V + t__ * D + h * 64 + half * 32 + 2 * cl); } while (0)
#define SCAN_PREP(RR, KR, AR, DR, VR, tok_, buf_, step_) do { const size_t t__ = (tok_); \
    const f32x4 r = (f32x4){bflo(RR.x), bfhi(RR.x), bflo(RR.y), bfhi(RR.y)}; \
    const f32x4 k = (f32x4){bflo(KR.x), bfhi(KR.x), bflo(KR.y), bfhi(KR.y)}; \
    const f32x4 a = (f32x4){bflo(AR.x), bfhi(AR.x), bflo(AR.y), bfhi(AR.y)}; \
    const f32x4 dcy = (f32x4){__expf(bflo(DR.x)), __expf(bfhi(DR.x)), __expf(bflo(DR.y)), __expf(bfhi(DR.y))}; \
    const f32x4 kkr = k * kk4; \
    const float ss = red16((kkr[0] * kkr[0] + kkr[1] * kkr[1]) + (kkr[2] * kkr[2] + kkr[3] * kkr[3])); \
    const float inv = 1.0f / sqrtf(fmaxf(ss, 1e-24f)); \
    const f32x4 kk = kkr * inv; \
    const f32x4 kp = k * (1.0f + (a - 1.0f) * ka4); \
    const f32x4 bv = kk * a; \
    const float bon = red16((r[0] * kp[0] * rk4[0] + r[1] * kp[1] * rk4[1]) + (r[2] * kp[2] * rk4[2] + r[3] * kp[3] * rk4[3])); \
    LAS float* rec = inb + (buf_) * (TC * SROW) + (step_) * SROW; \
    *(LAS f32x4*)(rec + 4 * cl) = dcy; *(LAS f32x4*)(rec + 64 + 4 * cl) = -kk; *(LAS f32x4*)(rec + 128 + 4 * cl) = bv; \
    *(LAS f32x4*)(rec + 192 + 4 * cl) = kp; *(LAS f32x4*)(rec + 256 + 4 * cl) = r; \
    *(LAS f32x2*)(rec + 320 + 2 * cl) = (f32x2){bflo(VR), bfhi(VR)}; \
    if (cl == 0 && half == 0) P.BONUS[t__ * 32 + h] = bon; } while (0)
__device__ __forceinline__ void scan_phase(const ScanP P, LAS unsigned char* lds, int G) {
    LAS float* inb = (LAS float*)lds;
    LAS float* ybuf = (LAS float*)(lds + 2 * TC * SROW * 4);
    const int tid = opaque_tid();
    const bool helper = tid >= 256;
    const int ht = tid & 255, cl = ht & 15, hrw = ht >> 4;
    const int c8 = tid & 7, r8 = (tid >> 3) & 31;
    for (int item = blockIdx.x; item < 256; item += G) {
        const int bh = item >> 1, half = item & 1, bt = bh >> 5, h = bh & 31;
        const int col = h * 64 + 4 * cl;
        const size_t tok0 = (size_t)bt * SEQ;
        f32x4 kk4 = (f32x4){0.f, 0.f, 0.f, 0.f}, ka4 = kk4, rk4 = kk4;
        u32x2 rA_ = (u32x2){0u, 0u}, kA_ = rA_, aA_ = rA_, rB_ = rA_, kB_ = rA_, aB_ = rA_, dA_ = rA_, dB_ = rA_; unsigned vA_ = 0u, vB_ = 0u;
        float tv[32]; int tpend = -1;
#pragma unroll
        for (int i = 0; i < 32; ++i) tv[i] = 0.f;
        if (helper) {
            kk4 = *(const f32x4*)(P.k_k + col); ka4 = *(const f32x4*)(P.k_a + col); rk4 = *(const f32x4*)(P.r_k + col);
            SCAN_LOADRAW(rA_, kA_, aA_, dA_, vA_, tok0 + hrw); SCAN_LOADRAW(rB_, kB_, aB_, dB_, vB_, tok0 + hrw + 16);
            SCAN_PREP(rA_, kA_, aA_, dA_, vA_, tok0 + hrw, 0, hrw); SCAN_PREP(rB_, kB_, aB_, dB_, vB_, tok0 + hrw + 16, 0, hrw + 16);
            SCAN_LOADRAW(rA_, kA_, aA_, dA_, vA_, tok0 + TC + hrw); SCAN_LOADRAW(rB_, kB_, aB_, dB_, vB_, tok0 + TC + hrw + 16);
        }
        f32x2 S01 = (f32x2){0.f, 0.f}, S23 = (f32x2){0.f, 0.f}, S45 = (f32x2){0.f, 0.f}, S67 = (f32x2){0.f, 0.f};
        __syncthreads();
        for (int c = 0; c < SEQ / TC; ++c) {
            const int buf = c & 1;
            if (helper) {
                if (c > 0) {
                    const int tt = ht >> 3, rq = ht & 7;
                    const f32x4 yv = *(const LAS f32x4*)(ybuf + (buf ^ 1) * (TC * 32) + tt * 32 + 4 * rq);
                    u32x2 yw; yw.x = cvt_pk_bf16(yv[0], yv[1]); yw.y = cvt_pk_bf16(yv[2], yv[3]);
                    *(u32x2*)(P.Y + (tok0 + (c - 1) * TC + tt) * D + h * 64 + half * 32 + 4 * rq) = yw;
                }
                if (c + 1 < SEQ / TC) {
                    SCAN_PREP(rA_, kA_, aA_, dA_, vA_, tok0 + (c + 1) * TC + hrw, buf ^ 1, hrw); SCAN_PREP(rB_, kB_, aB_, dB_, vB_, tok0 + (c + 1) * TC + hrw + 16, buf ^ 1, hrw + 16);
                    if (c + 2 < SEQ / TC) { SCAN_LOADRAW(rA_, kA_, aA_, dA_, vA_, tok0 + (c + 2) * TC + hrw); SCAN_LOADRAW(rB_, kB_, aB_, dB_, vB_, tok0 + (c + 2) * TC + hrw + 16); }
                }
                LAS float* scr = (LAS float*)(lds + 2 * TC * SROW * 4 + 2 * TC * 32 * 4 + ((tid >> 6) - 4) * 8448);
                const int ln = tid & 63;
                if (tpend >= 0) { TW_DECODE(P, tpend, src_, dst_, kk_, nn_, it_, rm_); (void)src_; titem_finish(kk_, nn_, dst_, scr, it_, ln, rm_, tv); }
                const int q = ((item - (int)blockIdx.x) / G) * (SEQ / TC) + c;
                const int ti = q * (G * 4) + (int)blockIdx.x * 4 + ((tid >> 6) - 4);
                tpend = -1;
                if (ti < TW_TOTAL) { tpend = ti; TW_DECODE(P, ti, src_, dst_, kk_, nn_, it_, rm_); (void)dst_; (void)kk_; (void)rm_; titem_issue(src_, nn_, it_, ln, tv); }
            } else {
                const LAS float* rb = inb + buf * (TC * SROW) + 8 * c8;
                const LAS float* vb = inb + buf * (TC * SROW) + 320 + r8;
                LAS float* yb = ybuf + buf * (TC * 32) + r8;
                f32x4 wA = *(const LAS f32x4*)(rb), wB = *(const LAS f32x4*)(rb + 4), nA = *(const LAS f32x4*)(rb + 64), nB = *(const LAS f32x4*)(rb + 68);
                f32x4 bA = *(const LAS f32x4*)(rb + 128), bB = *(const LAS f32x4*)(rb + 132), kA = *(const LAS f32x4*)(rb + 192), kB = *(const LAS f32x4*)(rb + 196);
                f32x4 rA = *(const LAS f32x4*)(rb + 256), rB = *(const LAS f32x4*)(rb + 260);
                float vv = vb[0];
                float ykeep = 0.f; float qa[8];
                const bool b0 = (c8 & 1) != 0, b1 = (c8 & 2) != 0, b2 = (c8 & 4) != 0;
#pragma unroll
                for (int tt = 0; tt < TC; ++tt) {
                    f32x4 wAn = wA, wBn = wB, nAn = nA, nBn = nB, bAn = bA, bBn = bB, kAn = kA, kBn = kB, rAn = rA, rBn = rB; float vvn = vv;
                    if (tt + 1 < TC) { const LAS float* rn = rb + (tt + 1) * SROW;
                        wAn = *(const LAS f32x4*)(rn); wBn = *(const LAS f32x4*)(rn + 4); nAn = *(const LAS f32x4*)(rn + 64); nBn = *(const LAS f32x4*)(rn + 68);
                        bAn = *(const LAS f32x4*)(rn + 128); bBn = *(const LAS f32x4*)(rn + 132); kAn = *(const LAS f32x4*)(rn + 192); kBn = *(const LAS f32x4*)(rn + 196);
                        rAn = *(const LAS f32x4*)(rn + 256); rBn = *(const LAS f32x4*)(rn + 260); vvn = vb[(tt + 1) * SROW]; }
                    __builtin_amdgcn_sched_barrier(0);
                    f32x2 p = S01 * nA.lo, p2 = S45 * nB.lo; p = S23 * nA.hi + p; p2 = S67 * nB.hi + p2; p = p + p2;
                    const float sa = red8(p.x + p.y);
                    f32x2 t01 = kA.lo * vv, t23 = kA.hi * vv, t45 = kB.lo * vv, t67 = kB.hi * vv;
                    t01 = bA.lo * sa + t01; t23 = bA.hi * sa + t23; t45 = bB.lo * sa + t45; t67 = bB.hi * sa + t67;
                    S01 = S01 * wA.lo + t01; S23 = S23 * wA.hi + t23; S45 = S45 * wB.lo + t45; S67 = S67 * wB.hi + t67;
                    f32x2 q = S01 * rA.lo, q2 = S45 * rB.lo; q = S23 * rA.hi + q; q2 = S67 * rB.hi + q2; q = q + q2;
                    qa[tt & 7] = q.x + q.y;
                    if ((tt & 7) == 7) {
                        float r4[4], r2[2];
#pragma unroll
                        for (int i = 0; i < 4; ++i) { const float keep = b0 ? qa[2 * i + 1] : qa[2 * i], send = b0 ? qa[2 * i] : qa[2 * i + 1]; r4[i] = keep + dppf<0xB1>(send); }
#pragma unroll
                        for (int i = 0; i < 2; ++i) { const float keep = b1 ? r4[2 * i + 1] : r4[2 * i], send = b1 ? r4[2 * i] : r4[2 * i + 1]; r2[i] = keep + dppf<0x4E>(send); }
                        const float keep = b2 ? r2[1] : r2[0], send = b2 ? r2[0] : r2[1];
                        ykeep = keep + __shfl_xor(send, 4);
                        yb[(tt - 7 + c8) * 32] = ykeep;
                    }
                    __builtin_amdgcn_sched_barrier(0);
                    wA = wAn; wB = wBn; nA = nAn; nB = nBn; bA = bAn; bB = bBn; kA = kAn; kB = kBn; rA = rAn; rB = rBn; vv = vvn;
                }
            }
            __syncthreads();
        }
        if (helper) {
            {   const int c = SEQ / TC - 1, tt = ht >> 3, rq = ht & 7;
                const f32x4 yv = *(const LAS f32x4*)(ybuf + (c & 1) * (TC * 32) + tt * 32 + 4 * rq);
                u32x2 yw; yw.x = cvt_pk_bf16(yv[0], yv[1]); yw.y = cvt_pk_bf16(yv[2], yv[3]);
                *(u32x2*)(P.Y + (tok0 + c * TC + tt) * D + h * 64 + half * 32 + 4 * rq) = yw; }
            if (tpend >= 0) {
                LAS float* scr = (LAS float*)(lds + 2 * TC * SROW * 4 + 2 * TC * 32 * 4 + ((tid >> 6) - 4) * 8448);
                const int ln = tid & 63;
                TW_DECODE(P, tpend, src_, dst_, kk_, nn_, it_, rm_); (void)src_; titem_finish(kk_, nn_, dst_, scr, it_, ln, rm_, tv);
            }
        }
        __syncthreads();
    }
}
#undef SCAN_LOADRAW
#undef SCAN_PREP
__device__ __forceinline__ void post_phase(const Ctx& C_unused, const bf16_t* Y, const bf16_t* V, const bf16_t* Gt, const float* BONUS, const float* gn_g, const float* gn_b, bf16_t* YG) {
    const Ctx C = mkctx();
    const int gt = C.gw * 64 + C.lane, NT = C.NGW * 64;
    for (int idx = gt; idx < M * (D / 4); idx += NT) {
        const int t = idx >> 9, c4 = idx & 511, h = c4 >> 4;
        const u32x2 yr = ((const u32x2*)Y)[idx];
        const f32x4 y = (f32x4){bflo(yr.x), bfhi(yr.x), bflo(yr.y), bfhi(yr.y)};
        const float mean = red16((y[0] + y[1]) + (y[2] + y[3])) * (1.f / 64.f);
        const f32x4 dlt = y - mean;
        const float var = red16((dlt[0] * dlt[0] + dlt[1] * dlt[1]) + (dlt[2] * dlt[2] + dlt[3] * dlt[3])) * (1.f / 64.f);
        const float rstd = 1.0f / sqrtf(var + GN_EPS);
        const f32x4 gg = ((const f32x4*)gn_g)[c4], gb = ((const f32x4*)gn_b)[c4];
        const u32x2 vr = ((const u32x2*)V)[idx], gr = ((const u32x2*)Gt)[idx];
        const f32x4 v = (f32x4){bflo(vr.x), bfhi(vr.x), bflo(vr.y), bfhi(vr.y)}, gate = (f32x4){bflo(gr.x), bfhi(gr.x), bflo(gr.y), bfhi(gr.y)};
        const float bon = BONUS[(size_t)t * 32 + h];
        const f32x4 o = (dlt * rstd * gg + gb + v * bon) * gate;
        u32x2 w; w.x = cvt_pk_bf16(o[0], o[1]); w.y = cvt_pk_bf16(o[2], o[3]); ((u32x2*)YG)[idx] = w;
    }
}

constexpr int KROWB = 272;
constexpr int VT_OFF = 256 * KROWB;
__device__ __forceinline__ void attn_phase(const bf16_t* QKV, bf16_t* OG, float* LSE, int dil, LAS unsigned char* lds, int G, int accum) {
    const int tid = opaque_tid(), lane = tid & 63, wave0 = __builtin_amdgcn_readfirstlane(tid >> 6), fr = lane & 15, fq = lane >> 4;
    const int nb = 32 / dil, RL = nb < 4 ? nb : 4, rpc = nb / RL, nitems = 2048 / RL;
    const int krow = tid >> 4, kch = tid & 15;
    const int vdch = tid >> 5, vkq = tid & 31;
    for (int item = blockIdx.x; item < nitems; item += G) {
        int wave = wave0; asm volatile("" : "+v"(wave));
        const int chain = item / rpc, run = item - chain * rpc;
        const int r = chain % dil, h = (chain / dil) & 15, bt = chain / (dil * 16);
        const int n0 = run * RL;
        const size_t tok0 = (size_t)bt * SEQ;
        const bf16_t* kbase = QKV + 2048 + h * 128 + kch * 8;
        const bf16_t* vbase = QKV + 4096 + h * 128 + vdch * 8;
        u32x4 kreg[4], vreg[4]; bf16x8 qn[4];
#define AT_LOAD(nn) do { _Pragma("unroll") for (int it = 0; it < 4; ++it) { const int pos = ((nn) * 128 + krow + 32 * it) * dil + r; kreg[it] = *(const u32x4*)(kbase + (tok0 + pos) * NQKV); } \
        _Pragma("unroll") for (int j = 0; j < 4; ++j) { const int pos = ((nn) * 128 + 4 * vkq + j) * dil + r; vreg[j] = *(const u32x4*)(vbase + (tok0 + pos) * NQKV); } } while (0)
#define AT_STORE(slot) do { _Pragma("unroll") for (int it = 0; it < 4; ++it) *(LAS u32x4*)(lds + ((slot) * 128 + krow + 32 * it) * KROWB + kch * 16) = kreg[it]; \
        _Pragma("unroll") for (int i = 0; i < 8; ++i) { unsigned e0, e1, e2, e3; \
            if (i & 1) { e0 = vreg[0][i >> 1] >> 16; e1 = vreg[1][i >> 1] >> 16; e2 = vreg[2][i >> 1] >> 16; e3 = vreg[3][i >> 1] >> 16; } \
            else { e0 = vreg[0][i >> 1] & 0xffffu; e1 = vreg[1][i >> 1] & 0xffffu; e2 = vreg[2][i >> 1] & 0xffffu; e3 = vreg[3][i >> 1] & 0xffffu; } \
            u32x2 w_; w_.x = e0 | (e1 << 16); w_.y = e2 | (e3 << 16); \
            *(LAS u32x2*)(lds + VT_OFF + (8 * vdch + i) * 512 + ((((slot) * 32 + vkq) ^ (4 * i) ^ (2 * (vdch & 1))) * 8)) = w_; } } while (0)
#define AT_LOADQ(nn) do { const size_t qt_ = tok0 + (size_t)(((nn) * 128 + 16 * wave + fr) * dil + r); \
        _Pragma("unroll") for (int ks = 0; ks < 4; ++ks) qn[ks] = *(const bf16x8*)(QKV + qt_ * NQKV + h * 128 + 32 * ks + 8 * fq); } while (0)
        if (n0 > 0) { AT_LOAD(n0 - 1); }
        else {
#pragma unroll
            for (int j = 0; j < 4; ++j) { kreg[j] = (u32x4){0u, 0u, 0u, 0u}; vreg[j] = (u32x4){0u, 0u, 0u, 0u}; } }
        AT_STORE((n0 & 1) ^ 1);
        AT_LOAD(n0); AT_LOADQ(n0);
        for (int n = n0; n < n0 + RL; ++n) {
            asm volatile("" : "+v"(wave));
            AT_STORE(n & 1);
            bf16x8 qf[4];
#pragma unroll
            for (int ks = 0; ks < 4; ++ks) qf[ks] = qn[ks];
            __syncthreads();
            if (n + 1 < n0 + RL) { AT_LOAD(n + 1); AT_LOADQ(n + 1); }
            const int flip = (n & 1) ^ 1;
            const int qi = 16 * wave + fr;
            const size_t qtok = tok0 + (size_t)((n * 128 + qi) * dil + r);
            f32x4 sc[10];
#pragma unroll
            for (int tt = 0; tt < 10; ++tt) {
                const int tile = ((wave + tt) < 15 ? (wave + tt) : 15) ^ (8 * flip);
                f32x4 acc = (f32x4){0.f, 0.f, 0.f, 0.f};
#pragma unroll
                for (int ks = 0; ks < 4; ++ks) {
                    const bf16x8 kf = *(const LAS bf16x8*)(lds + (16 * tile + fr) * KROWB + 64 * ks + 16 * fq);
                    acc = __builtin_amdgcn_mfma_f32_16x16x32_bf16(kf, qf[ks], acc, 0, 0, 0);
                }
                sc[tt] = acc;
            }
            constexpr float SC2 = 0.08838834764831845f * 1.4426950408889634f;
            float mx = -3.0e38f;
#pragma unroll
            for (int tt = 0; tt < 10; ++tt) {
                const bool tile_ok = (wave + tt <= 15) && (n > 0 || (wave + tt) >= 8);
#pragma unroll
                for (int j = 0; j < 4; ++j) {
                    bool valid = tile_ok;
                    if (tt == 0 || tt >= 8) { const int kj = 16 * (wave + tt) + 4 * fq + j; valid = valid && (kj >= qi) && (kj <= qi + 128); }
                    const float s = valid ? sc[tt][j] * SC2 : -1e30f;
                    sc[tt][j] = s; mx = fmaxf(mx, s);
                }
            }
            mx = fmaxf(mx, __shfl_xor(mx, 16)); mx = fmaxf(mx, __shfl_xor(mx, 32));
            float sum = 0.f;
#pragma unroll
            for (int tt = 0; tt < 10; ++tt)
#pragma unroll
                for (int j = 0; j < 4; ++j) { const float p = __builtin_amdgcn_exp2f(sc[tt][j] - mx); sc[tt][j] = p; sum += p; }
            sum += __shfl_xor(sum, 16); sum += __shfl_xor(sum, 32);
            bf16x8 pf[5];
#pragma unroll
            for (int s = 0; s < 5; ++s) {
                u32x4 w; w.x = cvt_pk_bf16(sc[2 * s][0], sc[2 * s][1]); w.y = cvt_pk_bf16(sc[2 * s][2], sc[2 * s][3]);
                w.z = cvt_pk_bf16(sc[2 * s + 1][0], sc[2 * s + 1][1]); w.w = cvt_pk_bf16(sc[2 * s + 1][2], sc[2 * s + 1][3]);
                pf[s] = __builtin_bit_cast(bf16x8, w);
            }
            const float inv = 1.0f / sum;
            bf16_t* orow = OG + qtok * D + h * 128 + 4 * fq;
            const float lse_g = (mx + __builtin_amdgcn_logf(sum)) * 0.6931471805599453f;
            float w_old = 0.f, w_new = inv, lse_out = lse_g;
            u32x2 oldv[8];
            if (accum) {
#pragma unroll
                for (int dt = 0; dt < 8; ++dt) oldv[dt] = *(const u32x2*)(orow + 16 * dt);
                const float lse_o = LSE[qtok * 16 + h];
                const float mxl = fmaxf(lse_o, lse_g), eo = __expf(lse_o - mxl), en = __expf(lse_g - mxl), rden = 1.0f / (eo + en);
                w_old = eo * rden; w_new = en * rden * inv; lse_out = mxl + __logf(eo + en);
            }
#pragma unroll
            for (int dt = 0; dt < 8; ++dt) {
                f32x4 o = (f32x4){0.f, 0.f, 0.f, 0.f};
                const LAS unsigned char* vrow = lds + VT_OFF + (16 * dt + fr) * 512;
                const int sw = (4 * (fr & 7)) ^ (2 * (fr >> 3));
#pragma unroll
                for (int s = 0; s < 5; ++s) {
                    const int tA = ((wave + 2 * s) < 15 ? (wave + 2 * s) : 15) ^ (8 * flip), tB = ((wave + 2 * s + 1) < 15 ? (wave + 2 * s + 1) : 15) ^ (8 * flip);
                    const u32x2 va = *(const LAS u32x2*)(vrow + (((4 * tA + fq) ^ sw) * 8)), vb = *(const LAS u32x2*)(vrow + (((4 * tB + fq) ^ sw) * 8));
                    const u32x4 vv = (u32x4){va.x, va.y, vb.x, vb.y};
                    o = __builtin_amdgcn_mfma_f32_16x16x32_bf16(__builtin_bit_cast(bf16x8, vv), pf[s], o, 0, 0, 0);
                }
                f32x4 r = o * w_new;
                if (accum) r = r + (f32x4){bflo(oldv[dt].x), bfhi(oldv[dt].x), bflo(oldv[dt].y), bfhi(oldv[dt].y)} * w_old;
                u32x2 w; w.x = cvt_pk_bf16(r[0], r[1]); w.y = cvt_pk_bf16(r[2], r[3]);
                *(u32x2*)(orow + 16 * dt) = w;
            }
            if (fq == 0) LSE[qtok * 16 + h] = lse_out;
            __syncthreads();
        }
#undef AT_LOAD
#undef AT_STORE
#undef AT_LOADQ
    }
}
__device__ __forceinline__ void merge_phase(const Ctx& C_unused, const bf16_t* OG, const float* LSE, bf16_t* OM) {
    const Ctx C = mkctx();
    const int gt = C.gw * 64 + C.lane, NT = C.NGW * 64;
    for (int idx = gt; idx < M * (D / 8); idx += NT) {
        const int t = idx >> 8, c8 = idx & 255, h = c8 >> 4;
        const float l0 = LSE[(size_t)t * 16 + h], l1 = LSE[(size_t)(M + t) * 16 + h], l2 = LSE[(size_t)(2 * M + t) * 16 + h];
        const float mx = fmaxf(l0, fmaxf(l1, l2));
        float w0 = __expf(l0 - mx), w1 = __expf(l1 - mx), w2 = __expf(l2 - mx);
        const float inv = 1.0f / (w0 + w1 + w2); w0 *= inv; w1 *= inv; w2 *= inv;
        const u32x4 a = ((const u32x4*)OG)[idx], b = ((const u32x4*)(OG + (size_t)M * D))[idx], c = ((const u32x4*)(OG + (size_t)2 * M * D))[idx];
        u32x4 o;
#pragma unroll
        for (int j = 0; j < 4; ++j) {
            const float lo = w0 * bflo(a[j]) + w1 * bflo(b[j]) + w2 * bflo(c[j]);
            const float hi = w0 * bfhi(a[j]) + w1 * bfhi(b[j]) + w2 * bfhi(c[j]);
            o[j] = cvt_pk_bf16(lo, hi);
        }
        ((u32x4*)OM)[idx] = o;
    }
}

#define XB_TMO      128
#define XB_XCNT(j)  (256  + 64 * (j))
#define XB_XSUB(j)  (1280 + 64 * (j))
#define XB_XGEN(j)  (2304 + 64 * (j))
#define XB_TOP      3328
#define XB_TOPGEN   3392
#define XCD_BAR_WORDS 3456
#define XB_SPIN_CAP (1u << 18)
constexpr size_t O_BAR = 512 * 1024;
__device__ __forceinline__ unsigned xb_ld(unsigned* p)              { return __hip_atomic_load(p, __ATOMIC_RELAXED, __HIP_MEMORY_SCOPE_AGENT); }
__device__ __forceinline__ unsigned xb_add(unsigned* p, unsigned v) { return __hip_atomic_fetch_add(p, v, __ATOMIC_RELAXED, __HIP_MEMORY_SCOPE_AGENT); }
__device__ __forceinline__ unsigned xb_xcc_id() { return (unsigned)__builtin_amdgcn_s_getreg((3 << 11) | 20) & 0xFu; }
#define XB_SPIN(cond, bar) do { unsigned _sp = 0; while (cond) { __builtin_amdgcn_s_sleep(1); \
    if ((++_sp & 255u) == 0u) { if (xb_ld(&(bar)[XB_TMO])) break; if (_sp > XB_SPIN_CAP) { atomicAdd(&(bar)[XB_TMO], 1u); break; } } } } while (0)
struct XcdBarrier { unsigned* bar; unsigned x; volatile LAS unsigned* st; };
__device__ __forceinline__ XcdBarrier xcd_barrier_post(unsigned* bar, volatile LAS unsigned* st) {
    XcdBarrier b; b.bar = bar; b.x = xb_xcc_id(); b.st = st;
    if (threadIdx.x == 0) (void)xb_add(&bar[XB_XCNT(b.x)], 1u);
    return b;
}
__device__ __forceinline__ void xcd_barrier_complete(unsigned* bar, unsigned x, unsigned& nloc, unsigned& nx) {
    const unsigned G = gridDim.x * gridDim.y * gridDim.z;
    unsigned sum, cnt, mine, sp = 0u;
    for (;;) {
        sum = 0u; cnt = 0u; mine = 0u;
#pragma unroll
        for (unsigned j = 0; j < 16; ++j) { const unsigned c = xb_ld(&bar[XB_XCNT(j)]); sum += c; cnt += (c > 0u) ? 1u : 0u; mine = (j == x) ? c : mine; }
        if (sum == G) break;
        __builtin_amdgcn_s_sleep(1);
        if ((++sp & 255u) == 0u) { if (xb_ld(&bar[XB_TMO])) break; if (sp > XB_SPIN_CAP) { atomicAdd(&bar[XB_TMO], 1u); break; } }
    }
    nloc = mine > 0u ? mine : 1u; nx = cnt > 0u ? cnt : 1u;
}
__device__ __forceinline__ void xcd_barrier(const XcdBarrier& b) {
    asm volatile("s_waitcnt vmcnt(0)" ::: "memory");
    __syncthreads();
    if (threadIdx.x == 0) {
        unsigned* bar = b.bar;
        __builtin_amdgcn_s_waitcnt(0);
        unsigned nloc = b.st[0], nx = b.st[1];
        if (nloc == 0u) { xcd_barrier_complete(bar, b.x, nloc, nx); b.st[0] = nloc; b.st[1] = nx; }
        const unsigned old = xb_add(&bar[XB_XSUB(b.x)], 1u);
        const unsigned gen = old / nloc;
        if (old + 1u == (gen + 1u) * nloc) {
            __builtin_amdgcn_fence(__ATOMIC_RELEASE, "agent");
            asm volatile("s_waitcnt vmcnt(0)" ::: "memory");
            const unsigned og = xb_add(&bar[XB_TOP], 1u);
            const unsigned tg = og / nx;
            if (og + 1u == (tg + 1u) * nx) xb_add(&bar[XB_TOPGEN], 1u);
            else XB_SPIN(xb_ld(&bar[XB_TOPGEN]) == tg, bar);
            __builtin_amdgcn_fence(__ATOMIC_ACQUIRE, "agent");
            xb_add(&bar[XB_XGEN(b.x)], 1u);
            asm volatile("s_waitcnt vmcnt(0)" ::: "memory");
        } else {
            XB_SPIN(xb_ld(&bar[XB_XGEN(b.x)]) == gen, bar);
            __builtin_amdgcn_fence(__ATOMIC_ACQUIRE, "agent");
            asm volatile("s_waitcnt vmcnt(0)" ::: "memory");
        }
    }
    __syncthreads();
}
__device__ __forceinline__ void seam_barrier(unsigned char* wsp, LAS unsigned char* lds) {
    XcdBarrier b; b.bar = (unsigned*)(wsp + O_BAR); b.x = xb_xcc_id(); b.st = (volatile LAS unsigned*)(lds + LDS_BYTES - 16);
    xcd_barrier(b);
}

__global__ void __launch_bounds__(512, 2) mega(Args args) {
    extern __shared__ __attribute__((aligned(16))) unsigned char smem[];
    LAS unsigned char* lds = (LAS unsigned char*)smem;
    cg::grid_group grid = cg::this_grid();
    if (threadIdx.x < 4) ((LAS unsigned*)(lds + LDS_BYTES - 16))[threadIdx.x] = 0u;
    __syncthreads();
    (void)xcd_barrier_post((unsigned*)(arg_ws() + O_BAR), (volatile LAS unsigned*)(lds + LDS_BYTES - 16));
    Ctx C; C.tid = threadIdx.x; C.lane = C.tid & 63; C.wave = __builtin_amdgcn_readfirstlane(C.tid >> 6); C.G = gridDim.x; C.gw = blockIdx.x * 8 + C.wave; C.NGW = C.G * 8;
#ifndef ENMASK
#define ENMASK 0xFFFFFFFFu
#endif
#define ws (arg_ws())
#define out (arg_out())
#define IN(k) (((ENMASK >> ((k) > 21 ? (k) - 13 : (k))) & 1u) && arg_int(232) <= (k) && (k) < arg_int(236))
#define SEAM(k) do { if (IN(k) && IN((k) + 1)) { if (arg_int(236) > 4096) grid.sync(); seam_barrier(ws, lds); } } while (0)
#ifndef REPMASK
#define REPMASK 0u
#endif
#define REPS(k) (((REPMASK >> (k)) & 1u) ? 2 : 1)
#define BT1 ((bf16_t*)(ws + O_BT1))
#define BT2 ((bf16_t*)(ws + O_BT2))
#define WOR ((bf16_t*)(ws + O_WOR))
#define WUP0 ((bf16_t*)(ws + O_WUP0))
#define WDN0 ((bf16_t*)(ws + O_WDN0))
#define Hb ((bf16_t*)(ws + O_H))
#define XM ((bf16_t*)(ws + O_XM))
#define DEC ((float*)(ws + O_DEC))
#define AA ((bf16_t*)(ws + O_AA))
#define RKV ((bf16_t*)(ws + O_RKV))
#define Gt ((bf16_t*)(ws + O_G))
#define BONUS ((float*)(ws + O_BONUS))
#define YG ((bf16_t*)(ws + O_YG))
#define STATS ((float*)ws)
#define RESB ((bf16_t*)(ws + O_RES))

    if (IN(0)) for (int rep = 0; rep < REPS(0); ++rep) {
        if (rep) grid.sync();
        for (int c = 0; c < 3; ++c) transpose_mat(C, lds, arg_in(2) + (size_t)c * D * D, D, D, BT1 + (size_t)c * D * D);
        transpose_mat(C, lds, arg_in(4), D, 96, BT1 + (size_t)6144 * D);
        zero_fill16(C, BT1 + (size_t)(6144 + 96) * D, (size_t)160 * D * 2 / 16);
        transpose_mat(C, lds, arg_in(7), D, 96, BT1 + (size_t)6400 * D);
        zero_fill16(C, BT1 + (size_t)(6400 + 96) * D, (size_t)160 * D * 2 / 16);
        transpose_mat(C, lds, arg_in(9), D, 256, BT1 + (size_t)6656 * D);
        transpose_pad96(C, arg_in(5), BT2);
        transpose_pad96(C, arg_in(8), BT2 + (size_t)2048 * 256);
        transpose_mat(C, lds, arg_in(10), 256, D, BT2 + (size_t)4096 * 256);
        mix_phase(C, arg_in(0), arg_in(1), 0, 2, 3, XM);
    }
    SEAM(0);
    if (IN(1)) {
        pg8::Gemm g{XM, BT1, D, D, D}; pg8::Order S; S.init(64, 8, 3, 64, C.G, (int)blockIdx.x);
        pg8::Epi<0> E{{RKV, nullptr, nullptr, nullptr, nullptr, (size_t)M * D, D, 8}};
        pg8::gemm_phase(lds, g, S, E);
    }
    SEAM(1);
    if (IN(2)) mix_phase(C, arg_in(0), arg_in(1), 1, 4, 5, XM);
    SEAM(2);
    if (IN(3)) {
        pg8::Gemm g{XM, BT1 + (size_t)6144 * D, D, D, D}; pg8::Order S; S.init(64, 1, 3, 64, C.G, (int)blockIdx.x);
        pg8::Epi<1> E{{Hb, nullptr, nullptr, nullptr, nullptr, (size_t)M * 256, 256, 1}};
        pg8::gemm_phase(lds, g, S, E);
    }
    SEAM(3);
    if (IN(4)) {
        pg8::Gemm g{Hb, BT2, 256, 256, 256}; pg8::Order S; S.init(64, 8, 3, 64, C.G, (int)blockIdx.x);
        pg8::Epi<2> E{{DEC, AA, Gt, arg_in(3), arg_in(6), 0, D, 8}};
        pg8::gemm_phase(lds, g, S, E);
    }
    SEAM(4);
    if (IN(5)) {
        ScanP P{RKV, RKV + (size_t)M * D, RKV + (size_t)2 * M * D, AA, (const bf16_t*)DEC, arg_in(11), arg_in(12), arg_in(13), (bf16_t*)out, BONUS,
                arg_in(19) + (size_t)D * FF2, arg_in(22) + (size_t)FF * D, arg_in(18), (bf16_t*)(ws + O_WUP1), (bf16_t*)(ws + O_WDN1), (bf16_t*)(ws + O_WOA),
                arg_in(19), arg_in(22), arg_in(16), WUP0, WDN0, WOR};
        for (int rep = 0; rep < REPS(5); ++rep) { if (rep) grid.sync(); scan_phase(P, lds, C.G); }
    }
    SEAM(5);
    if (IN(6)) post_phase(C, (const bf16_t*)out, RKV + (size_t)2 * M * D, Gt, BONUS, arg_in(14), arg_in(15), YG);
    SEAM(6);
    if (IN(7)) {
        pg8::Gemm g{YG, WOR, D, D, D}; pg8::Order S; S.init(64, 8, 1, 0, C.G, (int)blockIdx.x);
        pg8::Epi<3> E{{RESB, nullptr, nullptr, arg_in(0), nullptr, 0, D, 8}};
        pg8::gemm_phase(lds, g, S, E);
    }
    SEAM(7);
    if (IN(8)) ln_phase(C, RESB, arg_in(23), arg_in(24), nullptr, (bf16_t*)(ws + O_X1B), STATS);
    SEAM(8);
#pragma unroll 1
    for (int L = 0; L < 2; ++L) {
        const int pb = L == 0 ? 9 : 22;
        bf16_t* HF = (bf16_t*)(ws + (L == 0 ? O_HF0 : O_HF1));
        const bf16_t* XB = (const bf16_t*)(ws + (L == 0 ? O_X1B : O_X3B));
        const bf16_t* WUP = (const bf16_t*)(ws + (L == 0 ? O_WUP0 : O_WUP1));
        const bf16_t* WDN = (const bf16_t*)(ws + (L == 0 ? O_WDN0 : O_WDN1));
        if (L == 1) {
            bf16_t* X2B = (bf16_t*)(ws + O_X2B); bf16_t* WIN = (bf16_t*)(ws + O_WIN); bf16_t* WOA = (bf16_t*)(ws + O_WOA);
            bf16_t* QKV = (bf16_t*)(ws + O_QKV); bf16_t* OG = (bf16_t*)(ws + O_OG); float* LSE = (float*)(ws + O_LSE); bf16_t* OM = (bf16_t*)(ws + O_OM);
#pragma unroll 1
            for (int gi = 0; gi < 3; ++gi) {
                if (IN(13 + 2 * gi)) {
                    pg8::Gemm g{X2B, WIN + (size_t)gi * NQKV * D, D, D, D}; pg8::Order S; S.init(64, 24, 1, 0, C.G, (int)blockIdx.x);
                    pg8::Epi<0> E{{QKV, nullptr, nullptr, nullptr, nullptr, 0, NQKV, 24}};
                    pg8::gemm_phase(lds, g, S, E);
                }
                SEAM(13 + 2 * gi);
                if (IN(14 + 2 * gi)) attn_phase(QKV, OG, LSE, gi == 0 ? 1 : (gi == 1 ? 4 : 16), lds, C.G, gi > 0 ? 1 : 0);
                if (gi < 2) SEAM(14 + 2 * gi); else { if (IN(18) && IN(20)) seam_barrier(ws, lds); }
            }
            if (IN(20)) {
                pg8::Gemm g{OG, WOA, D, D, D}; pg8::Order S; S.init(64, 8, 1, 0, C.G, (int)blockIdx.x);
                pg8::Epi<4> E{{RESB, STATS, nullptr, arg_in(25), arg_in(26), 0, D, 8}};
                pg8::gemm_phase(lds, g, S, E);
            }
            SEAM(20);
            if (IN(21)) {
                ln_phase(C, RESB, arg_in(23) + D, arg_in(24) + D, nullptr, (bf16_t*)(ws + O_X3B), STATS);
            }
            SEAM(21);
        }
        if (IN(pb)) {
            pg8::Gemm g{XB, WUP, D, D, D}; pg8::Order S; S.init(64, 44, 1, 0, C.G, (int)blockIdx.x);
            pg8::Epi<5> E{{HF, (float*)(HF + (size_t)M * FF), (float*)(HF + (size_t)M * FF) + (size_t)256 * 4 * FF, arg_in(20) + (size_t)L * 3 * FF, arg_in(21) + (size_t)L * FF, 0, FF, 44}};
            pg8::gemm_phase(lds, g, S, E);
        }
        SEAM(pb);
        if (IN(pb + 1)) convfix_phase(C, HF, (const float*)(HF + (size_t)M * FF), (const float*)(HF + (size_t)M * FF) + (size_t)256 * 4 * FF, arg_in(20) + (size_t)L * 3 * FF, arg_in(21) + (size_t)L * FF);
        SEAM(pb + 1);
        if (IN(pb + 2)) {
            pg8::Gemm g{HF, WDN, FF, FF, FF}; pg8::Order S; S.init(64, 8, 1, 0, C.G, (int)blockIdx.x);
            pg8::Epi<4> E{{RESB, STATS, nullptr, arg_in(23) + (size_t)L * D, arg_in(24) + (size_t)L * D, 0, D, 8}};
            pg8::gemm_phase(lds, g, S, E);
        }
        SEAM(pb + 2);
        if (IN(pb + 3)) {
            if (L == 0) {
                ln_phase(C, RESB, arg_in(25), arg_in(26), nullptr, (bf16_t*)(ws + O_X2B), STATS);
                transpose_mat(C, lds, arg_in(17), D, 3 * NQKV, (bf16_t*)(ws + O_WIN));
            } else {
                ln_phase(C, RESB, arg_in(25) + D, arg_in(26) + D, out, nullptr, nullptr);
            }
        }
        if (L == 0) SEAM(12);
    }
#undef IN
#undef SEAM
#undef ws
#undef out
}

extern "C" void kernel_launch(void* const* d_in, const int* in_sizes, int n_in, void* d_out, int out_size, void* d_ws, size_t ws_size, hipStream_t stream) {
    static int grid = 0;
    if (grid == 0) {
        if (n_in != 27 || out_size != M * D || ws_size < WS_NEED) { fprintf(stderr, "kernel_launch: unexpected shapes (n_in %d, out %d, ws %zu)\n", n_in, out_size, ws_size); grid = -1; return; }
        int dev = 0, cus = 0, per_cu = 0;
        hipGetDevice(&dev);
        hipDeviceGetAttribute(&cus, hipDeviceAttributeMultiprocessorCount, dev);
        if (hipFuncSetAttribute((const void*)mega, hipFuncAttributeMaxDynamicSharedMemorySize, LDS_BYTES) != hipSuccess) { fprintf(stderr, "kernel_launch: hipFuncSetAttribute failed\n"); grid = -1; return; }
        if (hipOccupancyMaxActiveBlocksPerMultiprocessor(&per_cu, (const void*)mega, 512, LDS_BYTES) != hipSuccess || per_cu < 1) per_cu = 1;
        (void)hipGetLastError();
        grid = cus * 1;
    }
    if (grid < 0) return;
    if (hipMemsetAsync((char*)d_ws + O_BAR, 0, XCD_BAR_WORDS * 4, stream) != hipSuccess) { fprintf(stderr, "kernel_launch: memset of barrier words failed\n"); return; }
    Args a{};
    for (int i = 0; i < 27; ++i) a.in[i] = (const float*)d_in[i];
    a.out = (float*)d_out; a.ws = (unsigned char*)d_ws; a.ph_lo = 0; a.ph_hi = 26;
    void* kargs[] = {&a};
    hipError_t e = hipLaunchCooperativeKernel((const void*)mega, dim3(grid), dim3(512), kargs, LDS_BYTES, stream);
    if (e != hipSuccess) fprintf(stderr, "kernel_launch: cooperative launch failed: %s (grid %d)\n", hipGetErrorString(e), grid);
}
```
